# Optimizing an MI355X kernel written in HIP

```python
import jax, jax.numpy as jnp
from jax import lax
import numpy as np

D_MODEL = 1024
BATCH = 8
SEQ = 2048
DEPTH = 2
DEC_BATCH = 32
DEC_SEQ = 4
PAST_LEN = 16384
PAGE_SIZE = 128

EPS = 1e-6
N_MEM = 256
D_FF = 2816
DN_HEADS = 4
DN_DK = 128
DN_DV = 128
DN_CONV = 4
DN_CHUNK = 64
DN_QK_W = DN_HEADS * DN_DK
DN_V_W = DN_HEADS * DN_DV
DN_CONV_W = 2 * DN_QK_W + DN_V_W
SC_WIDTH = 512
SC_CONV = 3
MLA_HEADS = 8
MLA_Q_RANK = 256
MLA_KV_RANK = 256
MLA_NOPE = 64
MLA_ROPE = 32
MLA_V = 64
MLA_QK_HD = MLA_NOPE + MLA_ROPE
ROPE_THETA = 10000.0
Q_BLOCK = 128
MEM_HEADS = 4
MEM_HD = 128
MEM_W = MEM_HEADS * MEM_HD
N_BRANCH = 4
IN_SIZES = (DN_CONV_W, DN_V_W, DN_HEADS, DN_HEADS, SC_WIDTH, SC_WIDTH, SC_WIDTH,
            MLA_Q_RANK, MLA_KV_RANK, MLA_ROPE, MEM_W, N_BRANCH * D_MODEL)
N_IN = (DN_CONV_W + DN_V_W + 2 * DN_HEADS + 3 * SC_WIDTH + MLA_Q_RANK + MLA_KV_RANK
        + MLA_ROPE + MEM_W + N_BRANCH * D_MODEL)

kernel_name = 'hybrid_deltanet_conv_mla_memory_macaron_step'

F32 = jnp.float32


def _rmsnorm(x, g):
    x32 = x.astype(F32)
    y = x32 * lax.rsqrt(jnp.mean(x32 * x32, -1, keepdims=True) + EPS)
    return (y * g.astype(F32)).astype(x.dtype)


def _l2norm(x):
    x32 = x.astype(F32)
    return x32 * lax.rsqrt(jnp.sum(x32 * x32, -1, keepdims=True) + EPS)


def _swiglu(x, w_gu, w_down):
    gate, up = jnp.split(x @ w_gu, 2, axis=-1)
    return (jax.nn.silu(gate) * up) @ w_down


def _split_in(p):
    idx, acc = [], 0
    for s in IN_SIZES[:-1]:
        acc += s
        idx.append(acc)
    return jnp.split(p, idx, axis=-1)


def _causal_dwconv(x, prev, w):
    W, T = w.shape[0], x.shape[1]
    xx = jnp.concatenate([prev.astype(x.dtype), x], axis=1)
    y = sum(xx[:, j:j + T] * w[j] for j in range(W))
    return y, xx[:, xx.shape[1] - (W - 1):]


def _rope(x, pos):
    half = x.shape[-1] // 2
    inv = ROPE_THETA ** (-jnp.arange(half, dtype=F32) / half)
    ang = pos.astype(F32)[:, None] * inv
    ang = ang.reshape((pos.shape[0],) + (1,) * (x.ndim - 3) + (half,))
    cos, sin = jnp.cos(ang), jnp.sin(ang)
    x32 = x.astype(F32)
    x1, x2 = x32[..., :half], x32[..., half:]
    return jnp.concatenate([x1 * cos - x2 * sin, x2 * cos + x1 * sin], -1).astype(x.dtype)


def _gated_delta_rule(q, k, v, g, beta, S0):
    Bn, T, H, DK = q.shape
    DV = v.shape[-1]
    C = DN_CHUNK
    pad = (-T) % C

    def prep(a):
        a = a.astype(F32)
        a = jnp.pad(a, [(0, 0), (0, pad)] + [(0, 0)] * (a.ndim - 2))
        a = a.reshape((Bn, a.shape[1] // C, C) + a.shape[2:])
        return jnp.moveaxis(a, 3, 2)

    q, k, v, g, beta = prep(q), prep(k), prep(v), prep(g), prep(beta)
    q = q * DK ** -0.5
    gc = jnp.cumsum(g, axis=-1)
    incl = jnp.tril(jnp.ones((C, C), bool))
    strict = jnp.tril(jnp.ones((C, C), bool), -1)
    gam = jnp.exp(jnp.where(incl, gc[..., :, None] - gc[..., None, :], -jnp.inf))
    kb = k * beta[..., None]
    A = jnp.where(strict, jnp.einsum('bnhid,bnhjd->bnhij', kb, k) * gam, 0.0)
    M = A + jnp.eye(C, dtype=F32)
    rhs = jnp.concatenate([v * beta[..., None], kb * jnp.exp(gc)[..., None]], -1)
    sol = lax.linalg.triangular_solve(M, rhs, left_side=True, lower=True, unit_diagonal=True)
    u, w = sol[..., :DV], sol[..., DV:]
    aqk = jnp.einsum('bnhid,bnhjd->bnhij', q, k) * gam
    qg = q * jnp.exp(gc)[..., None]
    kdec = k * jnp.exp(gc[..., -1:] - gc)[..., None]
    glast = jnp.exp(gc[..., -1])

    def step(S, xs):
        u_i, w_i, qg_i, aqk_i, kdec_i, gl_i = xs
        v_new = u_i - jnp.einsum('bhcd,bhde->bhce', w_i, S)
        o = jnp.einsum('bhcd,bhde->bhce', qg_i, S) + jnp.einsum('bhij,bhje->bhie', aqk_i, v_new)
        S = S * gl_i[..., None, None] + jnp.einsum('bhcd,bhce->bhde', kdec_i, v_new)
        return S, o

    xs = tuple(jnp.moveaxis(a, 1, 0) for a in (u, w, qg, aqk, kdec, glast))
    S, o = lax.scan(step, S0.astype(F32), xs)
    o = jnp.transpose(o, (1, 0, 3, 2, 4)).reshape(Bn, -1, H, DV)[:, :T]
    return o, S


def _deltanet_branch(qkv, z, a, b, conv_prev, S0, conv_w, A_log, dt_bias, norm_g, w_out):
    Bn, T, _ = qkv.shape
    c, conv_new = _causal_dwconv(qkv, conv_prev, conv_w)
    c = jax.nn.silu(c)
    q, k, v = jnp.split(c, [DN_QK_W, 2 * DN_QK_W], axis=-1)
    q = _l2norm(q.reshape(Bn, T, DN_HEADS, DN_DK))
    k = _l2norm(k.reshape(Bn, T, DN_HEADS, DN_DK))
    v = v.reshape(Bn, T, DN_HEADS, DN_DV)
    g = -jnp.exp(A_log.astype(F32)) * jax.nn.softplus(a.astype(F32) + dt_bias.astype(F32))
    beta = jax.nn.sigmoid(b.astype(F32))
    o, S = _gated_delta_rule(q, k, v, g, beta, S0)
    zg = jax.nn.silu(z.astype(F32)).reshape(Bn, T, DN_HEADS, DN_DV)
    o = (_rmsnorm(o, norm_g) * zg).reshape(Bn, T, DN_V_W).astype(qkv.dtype)
    return o @ w_out, conv_new, S.astype(qkv.dtype)


def _shortconv_branch(bg, cg, xin, prev, conv_w, w_out):
    y, new_prev = _causal_dwconv(cg * xin, prev, conv_w)
    return (bg * y) @ w_out, new_prev


def _mla_project(cq, ckv_raw, kr_raw, pos, q_norm_a, w_q_b, kv_norm_a, q_norm):
    Bn, T, _ = cq.shape
    q = (_rmsnorm(cq, q_norm_a) @ w_q_b).reshape(Bn, T, MLA_HEADS, MLA_QK_HD)
    q = jnp.concatenate([q[..., :MLA_NOPE], _rope(q[..., MLA_NOPE:], pos)], -1)
    q = _rmsnorm(q, q_norm)
    ckv = _rmsnorm(ckv_raw, kv_norm_a)
    kr = _rope(kr_raw, pos)
    return q, ckv, kr


def _mla_w(w_kv_b):
    w = w_kv_b.reshape(MLA_KV_RANK, MLA_HEADS, MLA_NOPE + MLA_V)
    return w[..., :MLA_NOPE], w[..., MLA_NOPE:]


def _mla_keys(ckv, kr, w_kv_b, k_norm):
    w_uk, _ = _mla_w(w_kv_b)
    k_nope = jnp.einsum('...r,rhd->...hd', ckv, w_uk)
    k_rope = jnp.broadcast_to(kr[..., None, :], k_nope.shape[:-1] + (MLA_ROPE,))
    return _rmsnorm(jnp.concatenate([k_nope, k_rope], -1), k_norm)


def _mla_prompt_attn(q, ckv, kr, w_kv_b, k_norm):
    Bn, S = q.shape[:2]
    k = _mla_keys(ckv, kr, w_kv_b, k_norm)
    v = jnp.einsum('bsr,rhe->bshe', ckv, _mla_w(w_kv_b)[1])
    kpos = jnp.arange(S)
    scale = MLA_QK_HD ** -0.5

    def blk(i):
        qi = lax.dynamic_slice_in_dim(q, i * Q_BLOCK, Q_BLOCK, axis=1)
        s = jnp.einsum('bqhd,bkhd->bhqk', qi, k).astype(F32) * scale
        qpos = i * Q_BLOCK + jnp.arange(Q_BLOCK)
        s = jnp.where(kpos[None, :] <= qpos[:, None], s, -jnp.inf)
        p = jax.nn.softmax(s, axis=-1).astype(v.dtype)
        return jnp.einsum('bhqk,bkhe->bqhe', p, v)

    o = lax.map(blk, jnp.arange(S // Q_BLOCK))
    return jnp.moveaxis(o, 0, 1).reshape(Bn, S, MLA_HEADS * MLA_V)


def _mla_sample_attn(q, ckv_new, kr_new, ckv_pool, kr_pool, layer, page_table, w_kv_b, k_norm):
    DB, T = q.shape[:2]
    _, w_uv = _mla_w(w_kv_b)
    scale = MLA_QK_HD ** -0.5

    def one(args):
        pages, q_b, c_new, r_new = args
        c_all = jnp.concatenate([ckv_pool[layer, pages].reshape(-1, MLA_KV_RANK).astype(c_new.dtype), c_new], 0)
        r_all = jnp.concatenate([kr_pool[layer, pages].reshape(-1, MLA_ROPE).astype(r_new.dtype), r_new], 0)
        L = c_all.shape[0] - T
        k = _mla_keys(c_all, r_all, w_kv_b, k_norm)
        s = jnp.einsum('qhd,khd->hqk', q_b, k).astype(F32) * scale
        mask = jnp.arange(L + T)[None, :] <= L + jnp.arange(T)[:, None]
        s = jnp.where(mask, s, -jnp.inf)
        p = jax.nn.softmax(s, axis=-1).astype(c_all.dtype)
        pc = jnp.einsum('hqk,kr->qhr', p, c_all)
        return jnp.einsum('qhr,rhe->qhe', pc, w_uv)

    o = lax.map(one, (page_table, q, ckv_new, kr_new))
    return o.reshape(DB, T, MLA_HEADS * MLA_V)


def _mem_kv(mem, mem_norm, w_kv, k_norm):
    Bn, M, _ = mem.shape
    k, v = jnp.split(_rmsnorm(mem, mem_norm) @ w_kv, 2, axis=-1)
    k = _rmsnorm(k.reshape(Bn, M, MEM_HEADS, MEM_HD), k_norm)
    return k, v.reshape(Bn, M, MEM_HEADS, MEM_HD)


def _mem_attn(q_raw, mk, mv, q_norm, w_out):
    Bn, T, _ = q_raw.shape
    q = _rmsnorm(q_raw.reshape(Bn, T, MEM_HEADS, MEM_HD), q_norm)
    s = jnp.einsum('bqhd,bmhd->bhqm', q, mk.astype(q.dtype)).astype(F32) * MEM_HD ** -0.5
    p = jax.nn.softmax(s, axis=-1).astype(q.dtype)
    o = jnp.einsum('bhqm,bmhe->bqhe', p, mv.astype(q.dtype)).reshape(Bn, T, MEM_W)
    return o @ w_out


def _layer(x, pos, dn_conv_prev, dn_S0, sc_prev, mk, mv, mla_attend, w):
    Bn, T, D = x.shape
    x = x + 0.5 * _swiglu(_rmsnorm(x, w['ffn1_norm']), w['ffn1_w_gu'], w['ffn1_w_down'])
    h = _rmsnorm(x, w['mix_norm'])
    (dn_qkv, dn_z, dn_a, dn_b, sc_b, sc_c, sc_x,
     mla_q, mla_kv, mla_kr, mem_q, gates) = _split_in(h @ w['w_in'])
    y_dn, dn_conv_new, dn_S = _deltanet_branch(dn_qkv, dn_z, dn_a, dn_b, dn_conv_prev, dn_S0,
                                               w['dn_conv_w'], w['dn_A_log'], w['dn_dt_bias'],
                                               w['dn_norm'], w['dn_w_out'])
    y_sc, sc_new = _shortconv_branch(sc_b, sc_c, sc_x, sc_prev, w['sc_conv_w'], w['sc_w_out'])
    q, ckv, kr = _mla_project(mla_q, mla_kv, mla_kr, pos, w['mla_q_norm_a'], w['mla_w_q_b'],
                              w['mla_kv_norm_a'], w['mla_q_norm'])
    y_mla = mla_attend(q, ckv, kr) @ w['mla_w_out']
    y_mem = _mem_attn(mem_q, mk, mv, w['mem_q_norm'], w['mem_w_out'])
    g = jax.nn.sigmoid(gates.astype(F32)).astype(x.dtype).reshape(Bn, T, N_BRANCH, D)
    merged = g[..., 0, :] * y_dn + g[..., 1, :] * y_sc + g[..., 2, :] * y_mla + g[..., 3, :] * y_mem
    x = x + merged @ w['w_o']
    x = x + 0.5 * _swiglu(_rmsnorm(x, w['ffn2_norm']), w['ffn2_w_gu'], w['ffn2_w_down'])
    return x, dn_S, dn_conv_new, sc_new, ckv, kr


def setup_inputs(seed: int = 0) -> dict:
    key = jax.random.key(seed)
    ks = list(jax.random.split(key, 64))

    def nrm(shape, scale=1.0):
        return scale * jax.random.normal(ks.pop(), shape, F32)

    def gain(n):
        return jnp.ones((DEPTH, n), F32) + nrm((DEPTH, n), 0.02)

    n_pages = PAST_LEN // PAGE_SIZE
    n_phys = (5 * DEC_BATCH * n_pages + 3) // 4
    page_table = jax.random.permutation(ks.pop(), n_phys)[:DEC_BATCH * n_pages]
    page_table = page_table.reshape(DEC_BATCH, n_pages).astype(jnp.int32)
    dt = jnp.exp(jax.random.uniform(ks.pop(), (DEPTH, DN_HEADS), F32, np.log(1e-3), np.log(1e-1)))
    dt_bias = dt + jnp.log(-jnp.expm1(-dt))
    A_log = jnp.log(jax.random.uniform(ks.pop(), (DEPTH, DN_HEADS), F32, 1.0, 16.0))
    D = D_MODEL
    return {
        'x_prompt': nrm((BATCH, SEQ, D)),
        'x_sample': nrm((DEC_BATCH, DEC_SEQ, D)),
        'state_dn_S': nrm((DEPTH, DEC_BATCH, DN_HEADS, DN_DK, DN_DV), 0.1),
        'state_dn_conv': nrm((DEPTH, DEC_BATCH, DN_CONV - 1, DN_CONV_W)),
        'state_sc_conv': nrm((DEPTH, DEC_BATCH, SC_CONV - 1, SC_WIDTH)),
        'cache_mla_ckv': nrm((DEPTH, n_phys, PAGE_SIZE, MLA_KV_RANK)),
        'cache_mla_krope': nrm((DEPTH, n_phys, PAGE_SIZE, MLA_ROPE)),
        'cache_mem_k': nrm((DEPTH, DEC_BATCH, N_MEM, MEM_HEADS, MEM_HD)),
        'cache_mem_v': nrm((DEPTH, DEC_BATCH, N_MEM, MEM_HEADS, MEM_HD)),
        'page_table': page_table,
        'mem_prompt': nrm((BATCH, N_MEM, D)),
        'ffn1_norm': gain(D),
        'ffn1_w_gu': nrm((DEPTH, D, 2 * D_FF), D ** -0.5),
        'ffn1_w_down': nrm((DEPTH, D_FF, D), D_FF ** -0.5),
        'mix_norm': gain(D),
        'w_in': nrm((DEPTH, D, N_IN), D ** -0.5),
        'dn_conv_w': nrm((DEPTH, DN_CONV, DN_CONV_W), DN_CONV ** -0.5),
        'dn_A_log': A_log,
        'dn_dt_bias': dt_bias,
        'dn_norm': gain(DN_DV),
        'dn_w_out': nrm((DEPTH, DN_V_W, D), DN_V_W ** -0.5),
        'sc_conv_w': nrm((DEPTH, SC_CONV, SC_WIDTH), SC_CONV ** -0.5),
        'sc_w_out': nrm((DEPTH, SC_WIDTH, D), SC_WIDTH ** -0.5),
        'mla_q_norm_a': gain(MLA_Q_RANK),
        'mla_w_q_b': nrm((DEPTH, MLA_Q_RANK, MLA_HEADS * MLA_QK_HD), MLA_Q_RANK ** -0.5),
        'mla_kv_norm_a': gain(MLA_KV_RANK),
        'mla_w_kv_b': nrm((DEPTH, MLA_KV_RANK, MLA_HEADS * (MLA_NOPE + MLA_V)), MLA_KV_RANK ** -0.5),
        'mla_q_norm': gain(MLA_QK_HD),
        'mla_k_norm': gain(MLA_QK_HD),
        'mla_w_out': nrm((DEPTH, MLA_HEADS * MLA_V, D), (MLA_HEADS * MLA_V) ** -0.5),
        'mem_norm': gain(D),
        'mem_w_kv': nrm((DEPTH, D, 2 * MEM_W), D ** -0.5),
        'mem_q_norm': gain(MEM_HD),
        'mem_k_norm': gain(MEM_HD),
        'mem_w_out': nrm((DEPTH, MEM_W, D), MEM_W ** -0.5),
        'w_o': nrm((DEPTH, D, D), D ** -0.5),
        'ffn2_norm': gain(D),
        'ffn2_w_gu': nrm((DEPTH, D, 2 * D_FF), D ** -0.5),
        'ffn2_w_down': nrm((DEPTH, D_FF, D), D_FF ** -0.5),
    }


def reference(x_prompt, x_sample, state_dn_S, state_dn_conv, state_sc_conv, cache_mla_ckv,
              cache_mla_krope, cache_mem_k, cache_mem_v, page_table, mem_prompt,
              ffn1_norm, ffn1_w_gu, ffn1_w_down, mix_norm, w_in, dn_conv_w, dn_A_log, dn_dt_bias,
              dn_norm, dn_w_out, sc_conv_w, sc_w_out, mla_q_norm_a, mla_w_q_b, mla_kv_norm_a,
              mla_w_kv_b, mla_q_norm, mla_k_norm, mla_w_out, mem_norm, mem_w_kv, mem_q_norm,
              mem_k_norm, mem_w_out, w_o, ffn2_norm, ffn2_w_gu, ffn2_w_down):
    Bp, S, _ = x_prompt.shape
    Td = x_sample.shape[1]
    past = page_table.shape[1] * PAGE_SIZE
    pos_p = jnp.arange(S)
    pos_s = past + jnp.arange(Td)
    dt = x_prompt.dtype
    zero_S = jnp.zeros((Bp, DN_HEADS, DN_DK, DN_DV), F32)
    zero_dc = jnp.zeros((Bp, DN_CONV - 1, DN_CONV_W), dt)
    zero_sc = jnp.zeros((Bp, SC_CONV - 1, SC_WIDTH), dt)
    xp, xs = x_prompt, x_sample
    pS, pdc, psc, pckv, pkr, pmk, pmv = [], [], [], [], [], [], []
    sS, sdc, ssc, sckv, skr = [], [], [], [], []
    for l in range(DEPTH):
        w = dict(ffn1_norm=ffn1_norm[l], ffn1_w_gu=ffn1_w_gu[l], ffn1_w_down=ffn1_w_down[l],
                 mix_norm=mix_norm[l], w_in=w_in[l], dn_conv_w=dn_conv_w[l], dn_A_log=dn_A_log[l],
                 dn_dt_bias=dn_dt_bias[l], dn_norm=dn_norm[l], dn_w_out=dn_w_out[l],
                 sc_conv_w=sc_conv_w[l], sc_w_out=sc_w_out[l], mla_q_norm_a=mla_q_norm_a[l],
                 mla_w_q_b=mla_w_q_b[l], mla_kv_norm_a=mla_kv_norm_a[l], mla_q_norm=mla_q_norm[l],
                 mla_w_out=mla_w_out[l], mem_q_norm=mem_q_norm[l], mem_w_out=mem_w_out[l],
                 w_o=w_o[l], ffn2_norm=ffn2_norm[l], ffn2_w_gu=ffn2_w_gu[l], ffn2_w_down=ffn2_w_down[l])
        wkv, kn = mla_w_kv_b[l], mla_k_norm[l]
        mk, mv = _mem_kv(mem_prompt, mem_norm[l], mem_w_kv[l], mem_k_norm[l])
        xp, S_p, dc_p, sc_p, ckv_p, kr_p = _layer(
            xp, pos_p, zero_dc, zero_S, zero_sc, mk, mv,
            lambda q, c, r: _mla_prompt_attn(q, c, r, wkv, kn), w)
        pS.append(S_p); pdc.append(dc_p); psc.append(sc_p); pckv.append(ckv_p); pkr.append(kr_p)
        pmk.append(mk); pmv.append(mv)
        xs, S_s, dc_s, sc_s, ckv_s, kr_s = _layer(
            xs, pos_s, state_dn_conv[l], state_dn_S[l], state_sc_conv[l], cache_mem_k[l], cache_mem_v[l],
            lambda q, c, r: _mla_sample_attn(q, c, r, cache_mla_ckv, cache_mla_krope, l, page_table, wkv, kn), w)
        sS.append(S_s); sdc.append(dc_s); ssc.append(sc_s); sckv.append(ckv_s); skr.append(kr_s)
    p_dn_S = jnp.stack(pS)
    p_dn_conv = jnp.stack(pdc)
    p_sc_conv = jnp.stack(psc)
    p_mla_ckv = jnp.stack(pckv)
    p_mla_krope = jnp.stack(pkr)
    p_mem_k = jnp.stack(pmk)
    p_mem_v = jnp.stack(pmv)
    s_dn_S = jnp.stack(sS)
    s_dn_conv = jnp.stack(sdc)
    s_sc_conv = jnp.stack(ssc)
    s_mla_ckv = jnp.stack(sckv)
    s_mla_krope = jnp.stack(skr)
    return (xp, xs, p_dn_S, p_dn_conv, p_sc_conv, p_mla_ckv, p_mla_krope, p_mem_k, p_mem_v,
            s_dn_S, s_dn_conv, s_sc_conv, s_mla_ckv, s_mla_krope)
```

```cpp
#include <hip/hip_runtime.h>
#include <cstdio>
#include <cstdint>

#define GAS __attribute__((address_space(1)))
#define LAS __attribute__((address_space(3)))
typedef unsigned short bf16;
typedef unsigned v4u __attribute__((ext_vector_type(4)));
typedef unsigned v2u __attribute__((ext_vector_type(2)));
typedef float f32x4 __attribute__((ext_vector_type(4)));
typedef short bf16x8 __attribute__((ext_vector_type(8)));

constexpr int D = 1024, NB = 8, SEQ = 2048, DEPTH = 2, DBATCH = 32, DSEQ = 4, PAGE = 128, NPAGES = 128, NPHYS = 5120;
constexpr int MP = NB * SEQ;
constexpr int MS = DBATCH * DSEQ;
constexpr int MV = MP + MS;
constexpr int MT = 16640;
constexpr int DFF = 2816, NIN = 8744, NINP = 8960;
constexpr int NMEM = 256, NSEQ = NB + DBATCH;
constexpr float EPS = 1e-6f;
constexpr float LOG2E = 1.4426950408889634f;
constexpr int PC_QKV = 0, PC_Z = 1536, PC_SCB = 2048, PC_SCC = 2560, PC_SCX = 3072, PC_MQ = 3584, PC_MKV = 3840, PC_MEMQ = 4096, PC_GATE = 4608, PC_KR = 8704, PC_AB = 8736;

constexpr size_t O_YP = 0;
constexpr size_t O_YS = O_YP + (size_t)MP * D;
constexpr size_t O_PDNS = O_YS + (size_t)MS * D;
constexpr size_t O_PDNC = O_PDNS + (size_t)DEPTH * NB * 4 * 128 * 128;
constexpr size_t O_PSCC = O_PDNC + (size_t)DEPTH * NB * 3 * 1536;
constexpr size_t O_PCKV = O_PSCC + (size_t)DEPTH * NB * 2 * 512;
constexpr size_t O_PKR = O_PCKV + (size_t)DEPTH * NB * SEQ * 256;
constexpr size_t O_PMK = O_PKR + (size_t)DEPTH * NB * SEQ * 32;
constexpr size_t O_PMV = O_PMK + (size_t)DEPTH * NB * NMEM * 512;
constexpr size_t O_SDNS = O_PMV + (size_t)DEPTH * NB * NMEM * 512;
constexpr size_t O_SDNC = O_SDNS + (size_t)DEPTH * DBATCH * 4 * 128 * 128;
constexpr size_t O_SSCC = O_SDNC + (size_t)DEPTH * DBATCH * 3 * 1536;
constexpr size_t O_SCKV = O_SSCC + (size_t)DEPTH * DBATCH * 2 * 512;
constexpr size_t O_SKR = O_SCKV + (size_t)DEPTH * DBATCH * DSEQ * 256;
constexpr size_t O_END = O_SKR + (size_t)DEPTH * DBATCH * DSEQ * 32;
static_assert(O_END == 36306944, "output size");

constexpr size_t al256(size_t x) { return (x + 255) & ~(size_t)255; }
constexpr size_t WS_CTL = 0, CTL_ZERO_BYTES = 1u << 20;
constexpr int CW_BAR = 4096;

constexpr size_t WL_GU1 = 0;
constexpr size_t WL_D1 = WL_GU1 + (size_t)5632 * 1024 * 2;
constexpr size_t WL_IN = WL_D1 + (size_t)1024 * 2816 * 2;
constexpr size_t WL_DNO = WL_IN + (size_t)NINP * 1024 * 2;
constexpr size_t WL_SCO = WL_DNO + (size_t)1024 * 512 * 2;
constexpr size_t WL_MLAO = WL_SCO + (size_t)1024 * 512 * 2;
constexpr size_t WL_MEMO = WL_MLAO + (size_t)1024 * 512 * 2;
constexpr size_t WL_QB = WL_MEMO + (size_t)1024 * 512 * 2;
constexpr size_t WL_KVB = WL_QB + (size_t)1024 * 256 * 2;
constexpr size_t WL_WO = WL_KVB + (size_t)1024 * 256 * 2;
constexpr size_t WL_GU2 = WL_WO + (size_t)1024 * 1024 * 2;
constexpr size_t WL_D2 = WL_GU2 + (size_t)5632 * 1024 * 2;
constexpr size_t WL_SIZE = al256(WL_D2 + (size_t)1024 * 2816 * 2);
constexpr size_t WS_W = CTL_ZERO_BYTES;
constexpr size_t WS_WMEMKV = WS_W + 2 * WL_SIZE;
constexpr size_t WS_X = al256(WS_WMEMKV + (size_t)2048 * 1024 * 2);
constexpr size_t WS_XB = WS_X + (size_t)MT * D * 4;
constexpr size_t WS_ACT = WS_XB + (size_t)MT * D * 2;
constexpr size_t WS_P = WS_ACT + (size_t)MT * DFF * 2;
constexpr size_t WS_SIDE = WS_P + (size_t)MT * NINP * 2;
constexpr size_t WS_QKVN = WS_SIDE + (size_t)MT * 64 * 4;
constexpr size_t WS_GB = WS_QKVN + (size_t)MT * 1536 * 2;
constexpr size_t WS_ODN = WS_GB + (size_t)MT * 8 * 4;
constexpr size_t WS_OSC = WS_ODN + (size_t)MT * 512 * 2;
constexpr size_t WS_OMLA = WS_OSC + (size_t)MT * 512 * 2;
constexpr size_t WS_OMEM = WS_OMLA + (size_t)MT * 512 * 2;
constexpr size_t WS_CQB = WS_OMEM + (size_t)MT * 512 * 2;
constexpr size_t WS_CKVB = WS_CQB + (size_t)MT * 256 * 2;
constexpr size_t WS_KRB = WS_CKVB + (size_t)MT * 256 * 2;
constexpr size_t WS_QMB = WS_KRB + (size_t)MT * 32 * 4;
constexpr size_t WS_QRAW = WS_QMB + (size_t)MT * 512 * 2;
constexpr size_t WS_KVRAW = WS_QRAW + (size_t)MT * 1024 * 2;
constexpr size_t WS_QF = WS_KVRAW + (size_t)MT * 1024 * 2;
constexpr size_t WS_QSG = WS_QF + (size_t)MT * 768 * 2;
constexpr size_t WS_KF = WS_QSG + (size_t)MS * 768 * 2;
constexpr size_t WS_KFS = WS_KF + (size_t)MP * 768 * 2;
constexpr size_t WS_VT = WS_KFS + (size_t)MS * 768 * 2;
constexpr size_t WS_ORAW = WS_VT + (size_t)64 * 64 * 2048 * 2;
constexpr size_t WS_MERGED = WS_ORAW + (size_t)MT * 512 * 4;
constexpr size_t WS_WUKS = WS_MERGED;
constexpr size_t WS_MB = WS_MERGED + (size_t)MT * D * 4;
constexpr size_t WS_MEMB = WS_MB + (size_t)MT * D * 2;
constexpr size_t WS_MK = WS_MEMB + (size_t)2048 * 1024 * 2;
constexpr size_t WS_MVT = WS_MK + (size_t)2 * NSEQ * 4 * 256 * 128 * 2;
constexpr size_t WS_PART = WS_MVT + (size_t)2 * NSEQ * 4 * 256 * 128 * 2;
constexpr size_t WS_ML = WS_PART + (size_t)32 * 32 * 32 * 256 * 4;
constexpr size_t WS_ROPE = WS_ML + (size_t)32 * 32 * 32 * 2 * 4;
constexpr size_t WS_TAB = al256(WS_ROPE + (size_t)2052 * 32 * 4);
constexpr size_t WS_SSQ = al256(WS_TAB + 64 * 8);
constexpr size_t WS_DNC = al256(WS_SSQ + 7 * (size_t)MT * 16 * 4);
constexpr size_t WS_DNC_BYTES = (size_t)100 << 20;
constexpr size_t WS_END = al256(WS_DNC + WS_DNC_BYTES);

constexpr int LDS_BYTES = 147456;
constexpr int RING_BYTES = 131072;
constexpr int MISC_OFF = RING_BYTES + 320;
constexpr int NWAVES = 8;

#define RLX_AGENT __ATOMIC_RELAXED, __HIP_MEMORY_SCOPE_AGENT
__device__ __forceinline__ unsigned f2bf(float f) { unsigned u = __builtin_bit_cast(unsigned, f); return (u + 0x7fffu + ((u >> 16) & 1u)) >> 16; }
__device__ __forceinline__ unsigned pk2(float lo, float hi) { unsigned r; asm("v_cvt_pk_bf16_f32 %0, %1, %2" : "=v"(r) : "v"(lo), "v"(hi)); return r; }
__device__ __forceinline__ float bflo(unsigned w) { return __builtin_bit_cast(float, w << 16); }
__device__ __forceinline__ float bfhi(unsigned w) { return __builtin_bit_cast(float, w & 0xffff0000u); }
__device__ __forceinline__ float bf2f(bf16 b) { return __builtin_bit_cast(float, ((unsigned)b) << 16); }
__device__ __forceinline__ float fexp2(float x) { return __builtin_amdgcn_exp2f(x); }
__device__ __forceinline__ float frcp(float x) { return __builtin_amdgcn_rcpf(x); }
__device__ __forceinline__ float silu_f(float x) { return x * frcp(1.0f + fexp2(-x * LOG2E)); }
__device__ __forceinline__ float sigmoid_f(float x) { return frcp(1.0f + fexp2(-x * LOG2E)); }
__device__ __forceinline__ void unpack8(v4u w, float* f) { f[0] = bflo(w.x); f[1] = bfhi(w.x); f[2] = bflo(w.y); f[3] = bfhi(w.y); f[4] = bflo(w.z); f[5] = bfhi(w.z); f[6] = bflo(w.w); f[7] = bfhi(w.w); }
__device__ __forceinline__ v4u pack8(const float* f) { v4u w; w.x = pk2(f[0], f[1]); w.y = pk2(f[2], f[3]); w.z = pk2(f[4], f[5]); w.w = pk2(f[6], f[7]); return w; }
template <int CTRL> __device__ __forceinline__ float dppf(float v) { return __builtin_bit_cast(float, __builtin_amdgcn_update_dpp(0, __builtin_bit_cast(int, v), CTRL, 0xf, 0xf, true)); }
__device__ __forceinline__ float rsq_f(float x) { return __builtin_amdgcn_rsqf(x); }
__device__ __forceinline__ float row4_sum(float v) { v += dppf<0xB1>(v); v += dppf<0x4E>(v); return v; }
__device__ __forceinline__ float row8_sum(float v) { v = row4_sum(v); v += dppf<0x141>(v); return v; }
__device__ __forceinline__ float sum16(float v) { v = row8_sum(v); v += dppf<0x140>(v); return v; }
__device__ __forceinline__ float max16(float v) { v = fmaxf(v, dppf<0xB1>(v)); v = fmaxf(v, dppf<0x4E>(v)); v = fmaxf(v, dppf<0x141>(v)); v = fmaxf(v, dppf<0x140>(v)); return v; }
__device__ __forceinline__ float xsum16(float v) { return v + __shfl_xor(v, 16); }
__device__ __forceinline__ float xsum32(float v) { return v + __shfl_xor(v, 32); }
__device__ __forceinline__ float xmax16(float v) { return fmaxf(v, __shfl_xor(v, 16)); }
__device__ __forceinline__ float xmax32(float v) { return fmaxf(v, __shfl_xor(v, 32)); }
__device__ __forceinline__ float xrow_sum(float v) { return xsum32(xsum16(v)); }
__device__ __forceinline__ float xrow_max(float v) { return xmax32(xmax16(v)); }
__device__ __forceinline__ float wave_sum(float v) { return xrow_sum(sum16(v)); }
namespace pg8 {
#define PG8_LAS __attribute__((address_space(3)))
typedef unsigned short bf16_t;
typedef short bf16x8 __attribute__((ext_vector_type(8)));
typedef float f32x4 __attribute__((ext_vector_type(4)));
typedef unsigned u32x4 __attribute__((ext_vector_type(4)));
constexpr int BM = 256, BK = 64, HALF = 128, HTB = HALF * BK * 2  , STAGE_BYTES = 8 * HTB, NXCD = 8, WGM = 8;

__host__ __device__ __forceinline__ int lds_byte(int r, int c) { const int st = (r >> 4) * 2 + (c >> 5), rr = r & 15, cc = c & 31, ob = rr * 64 + cc * 2; return st * 1024 + (ob ^ (((ob >> 9) & 1) << 5)); }
__host__ __device__ __forceinline__ void stage_rc(int b, int& R, int& C) { const int st = b / 1024, sb = b % 1024, swz = sb ^ (((sb >> 9) & 1) << 5); R = (st >> 1) * 16 + swz / 64; C = (st & 1) * 32 + (swz % 64) / 2; }
__host__ __device__ __forceinline__ int perm32(int rho) { const int n = rho >> 4, i = rho & 15; return 8 * (i >> 2) + 4 * n + (i & 3); }

struct Unit { int pm, pn; };
struct Gemm { const bf16_t* A; const bf16_t* Bt; int M, N, K, lda; };

struct StaticOrder {
    int nM, nN, nwg, G, c;
    __host__ __device__ void init(int M, int N, int G_, int c_) { nM = M / BM; nN = N / BM; nwg = nM * nN; G = G_; c = c_; }
    __host__ __device__ bool next(int i, Unit& u) const {
        const long L = (long)i * G + c; if (L >= nwg) return false;
        int wgid = (int)L; { const int q = nwg / NXCD, r = nwg % NXCD, xcd = wgid % NXCD, off = wgid / NXCD; wgid = (xcd < r ? xcd * (q + 1) : r * (q + 1) + (xcd - r) * q) + off; }
        const int nig = WGM * nN, gid = wgid / nig, fm = gid * WGM, gsz = (nM - fm) < WGM ? (nM - fm) : WGM;
        u.pm = fm + ((wgid % nig) % gsz); u.pn = (wgid % nig) / gsz; return true;
    }
    __device__ __forceinline__ void a_ready(const Unit&) const {}
    __device__ __forceinline__ void done(const Unit&) const {}
};

__device__ __forceinline__ unsigned cvt_pk_bf16(float lo, float hi) { unsigned r; asm volatile("v_cvt_pk_bf16_f32 %0, %1, %2" : "=v"(r) : "v"(lo), "v"(hi)); return r; }
typedef float f32x2 __attribute__((ext_vector_type(2)));
typedef unsigned u32x2 __attribute__((ext_vector_type(2)));
__device__ __forceinline__ float ep_rstd(const float* ssq, int row) {
    const f32x4 a = *(const f32x4*)(ssq + (size_t)row * 16), b = *(const f32x4*)(ssq + (size_t)row * 16 + 4), c = *(const f32x4*)(ssq + (size_t)row * 16 + 8), d = *(const f32x4*)(ssq + (size_t)row * 16 + 12);
    const float s = (((a[0] + a[1]) + (a[2] + a[3])) + ((b[0] + b[1]) + (b[2] + b[3]))) + (((c[0] + c[1]) + (c[2] + c[3])) + ((d[0] + d[1]) + (d[2] + d[3])));
    return rsq_f(s * (1.0f / 1024.0f) + 1e-6f); }
__device__ __forceinline__ void ep_rstd8(const float* ssq, int row0, int fq, float (&rsv)[2][4]) {
    f32x4 q[2][4];
#pragma unroll
    for (int ai = 0; ai < 2; ++ai)
#pragma unroll
        for (int m = 0; m < 4; ++m) q[ai][m] = *(const f32x4*)(ssq + (size_t)(row0 + ai * 128 + m * 16) * 16 + 4 * fq);
#pragma unroll
    for (int ai = 0; ai < 2; ++ai)
#pragma unroll
        for (int m = 0; m < 4; ++m) { float s = (q[ai][m][0] + q[ai][m][1]) + (q[ai][m][2] + q[ai][m][3]); s = xrow_sum(s); rsv[ai][m] = rsq_f(s * (1.0f / 1024.0f) + 1e-6f); }
}
__device__ __forceinline__ float ep_silu(float x) { return x * __builtin_amdgcn_rcpf(1.0f + __builtin_amdgcn_exp2f(-x * 1.4426950408889634f)); }
__device__ __forceinline__ float ep_sigm(float x) { return __builtin_amdgcn_rcpf(1.0f + __builtin_amdgcn_exp2f(-x * 1.4426950408889634f)); }
struct EpiSwiglu {
    static constexpr bool PERM = true, AFTER_DRAIN = false, RSTD = true;
    bf16_t* O; int ldo; const float* ssq;
    __device__ __forceinline__ void operator()(const f32x4 (&acc)[2][2][4][2], const Unit& u, int wr, int wc, int fr, int fq, const float (&rsv)[2][4]) const {
        const int row0 = u.pm * BM + wr * 64 + fr, col0 = u.pn * 128 + wc * 32 + 8 * fq;
#pragma unroll
        for (int ai = 0; ai < 2; ++ai)
#pragma unroll
            for (int m = 0; m < 4; ++m) { const int row = row0 + ai * HALF + m * 16; const float rs = rsv[ai][m];
                const f32x4 g0 = acc[ai][0][m][0] * rs, g1 = acc[ai][0][m][1] * rs, u0 = acc[ai][1][m][0] * rs, u1 = acc[ai][1][m][1] * rs;
                u32x4 w; w.x = cvt_pk_bf16(ep_silu(g0[0]) * u0[0], ep_silu(g0[1]) * u0[1]); w.y = cvt_pk_bf16(ep_silu(g0[2]) * u0[2], ep_silu(g0[3]) * u0[3]);
                w.z = cvt_pk_bf16(ep_silu(g1[0]) * u1[0], ep_silu(g1[1]) * u1[1]); w.w = cvt_pk_bf16(ep_silu(g1[2]) * u1[2], ep_silu(g1[3]) * u1[3]);
                *(u32x4*)(O + (size_t)row * ldo + col0) = w; }
    }
};
struct EpiResid {
    static constexpr bool PERM = false, AFTER_DRAIN = false, RSTD = false;
    const float* xin; float* xout; bf16_t* xb; float* ssq; float scale; int row_limit;
    __device__ __forceinline__ void operator()(const f32x4 (&acc)[2][2][4][2], const Unit& u, int wr, int wc, int fr, int fq) const {
        const int row0 = u.pm * BM + wr * 64 + fr, col0 = u.pn * BM + wc * 32 + 4 * fq;
#pragma unroll
        for (int ai = 0; ai < 2; ++ai) {
            f32x4 xv[4][2][2];
#pragma unroll
            for (int m = 0; m < 4; ++m)
#pragma unroll
                for (int bj = 0; bj < 2; ++bj)
#pragma unroll
                    for (int n = 0; n < 2; ++n) xv[m][bj][n] = *(const f32x4*)(xin + (size_t)(row0 + ai * HALF + m * 16) * 1024 + col0 + bj * HALF + n * 16);
            __builtin_amdgcn_sched_barrier(0);
#pragma unroll
            for (int m = 0; m < 4; ++m) { const int row = row0 + ai * HALF + m * 16; const bool ok = row < row_limit; float ss = 0.f;
#pragma unroll
                for (int bj = 0; bj < 2; ++bj)
#pragma unroll
                    for (int n = 0; n < 2; ++n) { const size_t off = (size_t)row * 1024 + col0 + bj * HALF + n * 16;
                        const f32x4 x = xv[m][bj][n] + acc[ai][bj][m][n] * scale;
                        if (ok) { *(f32x4*)(xout + off) = x; u32x2 w; w.x = cvt_pk_bf16(x[0], x[1]); w.y = cvt_pk_bf16(x[2], x[3]); *(u32x2*)(xb + off) = w; }
                        ss += (x[0] * x[0] + x[1] * x[1]) + (x[2] * x[2] + x[3] * x[3]); }
                ss = xrow_sum(ss);
                if (ok && fq == 0) ssq[(size_t)row * 16 + u.pn * 4 + wc] = ss; }
        }
    }
};
struct EpiWin {
    static constexpr bool PERM = true, AFTER_DRAIN = false, RSTD = true;
    bf16_t* P; float* side; const float* ssq;
    __device__ __forceinline__ void operator()(const f32x4 (&acc)[2][2][4][2], const Unit& u, int wr, int wc, int fr, int fq, const float (&rsv)[2][4]) const {
        const int row0 = u.pm * BM + wr * 64 + fr, colt = wc * 32 + 8 * fq; const bool sg = (u.pn >= 18 && u.pn < 34);
#pragma unroll
        for (int ai = 0; ai < 2; ++ai)
#pragma unroll
            for (int m = 0; m < 4; ++m) { const int row = row0 + ai * HALF + m * 16; const float rs = rsv[ai][m];
#pragma unroll
                for (int bj = 0; bj < 2; ++bj) { f32x4 v0 = acc[ai][bj][m][0] * rs, v1 = acc[ai][bj][m][1] * rs; const int cl = colt + bj * HALF;
                    if (u.pn == 34 && cl < 40) { *(f32x4*)(side + (size_t)row * 64 + cl) = v0; *(f32x4*)(side + (size_t)row * 64 + cl + 4) = v1; }
                    if (sg) {
#pragma unroll
                        for (int j = 0; j < 4; ++j) { v0[j] = ep_sigm(v0[j]); v1[j] = ep_sigm(v1[j]); } }
                    u32x4 w; w.x = cvt_pk_bf16(v0[0], v0[1]); w.y = cvt_pk_bf16(v0[2], v0[3]); w.z = cvt_pk_bf16(v1[0], v1[1]); w.w = cvt_pk_bf16(v1[2], v1[3]);
                    *(u32x4*)(P + (size_t)row * 8960 + u.pn * BM + cl) = w; } }
    }
};
struct EpiPlain {
    static constexpr bool PERM = true, AFTER_DRAIN = false, RSTD = false;
    bf16_t* O; int ldo;
    __device__ __forceinline__ void operator()(const f32x4 (&acc)[2][2][4][2], const Unit& u, int wr, int wc, int fr, int fq) const {
        const int row0 = u.pm * BM + wr * 64 + fr, col0 = u.pn * BM + wc * 32 + 8 * fq;
#pragma unroll
        for (int ai = 0; ai < 2; ++ai)
#pragma unroll
            for (int m = 0; m < 4; ++m) { const int row = row0 + ai * HALF + m * 16;
#pragma unroll
                for (int bj = 0; bj < 2; ++bj) { const f32x4 v0 = acc[ai][bj][m][0], v1 = acc[ai][bj][m][1];
                    u32x4 w; w.x = cvt_pk_bf16(v0[0], v0[1]); w.y = cvt_pk_bf16(v0[2], v0[3]); w.z = cvt_pk_bf16(v1[0], v1[1]); w.w = cvt_pk_bf16(v1[2], v1[3]);
                    *(u32x4*)(O + (size_t)row * ldo + col0 + bj * HALF) = w; } }
    }
};
struct EpiGate {
    static constexpr bool PERM = true, AFTER_DRAIN = false, RSTD = false;
    const bf16_t* P; bf16_t* mb; int branch;
    __device__ __forceinline__ void operator()(const f32x4 (&acc)[2][2][4][2], const Unit& u, int wr, int wc, int fr, int fq) const {
        const int row0 = u.pm * BM + wr * 64 + fr, col0 = u.pn * BM + wc * 32 + 8 * fq;
#pragma unroll
        for (int ai = 0; ai < 2; ++ai)
#pragma unroll
            for (int m = 0; m < 4; ++m) { const int row = row0 + ai * HALF + m * 16;
#pragma unroll
                for (int bj = 0; bj < 2; ++bj) { const int c = col0 + bj * HALF; const size_t off = (size_t)row * 1024 + c;
                    const u32x4 gw = *(const u32x4*)(P + (size_t)row * 8960 + 4608 + branch * 1024 + c);
                    float x[8];
#pragma unroll
                    for (int j = 0; j < 4; ++j) { x[2 * j] = __builtin_bit_cast(float, gw[j] << 16) * acc[ai][bj][m][j >> 1][2 * (j & 1)]; x[2 * j + 1] = __builtin_bit_cast(float, gw[j] & 0xffff0000u) * acc[ai][bj][m][j >> 1][2 * (j & 1) + 1]; }
                    if (branch > 0) { const u32x4 mw = *(const u32x4*)(mb + off);
#pragma unroll
                        for (int j = 0; j < 4; ++j) { x[2 * j] += __builtin_bit_cast(float, mw[j] << 16); x[2 * j + 1] += __builtin_bit_cast(float, mw[j] & 0xffff0000u); } }
                    u32x4 w; w.x = cvt_pk_bf16(x[0], x[1]); w.y = cvt_pk_bf16(x[2], x[3]); w.z = cvt_pk_bf16(x[4], x[5]); w.w = cvt_pk_bf16(x[6], x[7]);
                    *(u32x4*)(mb + off) = w; } }
    }
};
struct EpiMemKV {
    static constexpr bool PERM = false, AFTER_DRAIN = false, RSTD = false;
    float* outk; size_t kv_stride;
    __device__ __forceinline__ void operator()(const f32x4 (&acc)[2][2][4][2], const Unit& u, int wr, int wc, int fr, int fq) const {
        const int row0 = u.pm * BM + wr * 64 + fr, layer = u.pn >> 2, kv = (u.pn >> 1) & 1, col0 = (u.pn & 1) * BM + wc * 32 + 4 * fq;
        float* base = outk + (size_t)kv * kv_stride + (size_t)layer * 2048 * 512;
#pragma unroll
        for (int ai = 0; ai < 2; ++ai)
#pragma unroll
            for (int m = 0; m < 4; ++m) { const int row = row0 + ai * HALF + m * 16;
#pragma unroll
                for (int bj = 0; bj < 2; ++bj)
#pragma unroll
                    for (int n = 0; n < 2; ++n) *(f32x4*)(base + (size_t)row * 512 + col0 + bj * HALF + n * 16) = acc[ai][bj][m][n]; }
    }
};

struct MultiOrder : StaticOrder {
    int nb, pmstride, pnstride;
    __device__ __forceinline__ bool next(int i, Unit& u) const { Unit b; if (!StaticOrder::next(i / nb, b)) return false; const int g = i % nb; u.pm = b.pm + g * pmstride; u.pn = b.pn + g * pnstride; return true; }
};
struct EpiGateM {
    static constexpr bool PERM = true, AFTER_DRAIN = false, RSTD = false;
    const bf16_t* P; bf16_t* mb;
    __device__ __forceinline__ void operator()(const f32x4 (&acc)[2][2][4][2], const Unit& u, int wr, int wc, int fr, int fq) const {
        const int branch = u.pn >> 2, pn = u.pn & 3, pm = u.pm - 65 * branch;
        const int row0 = pm * BM + wr * 64 + fr, col0 = pn * BM + wc * 32 + 8 * fq;
#pragma unroll
        for (int ai = 0; ai < 2; ++ai) {
            u32x4 gw[4][2], mw[4][2];
#pragma unroll
            for (int m = 0; m < 4; ++m)
#pragma unroll
                for (int bj = 0; bj < 2; ++bj) { const int row = row0 + ai * HALF + m * 16, c = col0 + bj * HALF;
                    gw[m][bj] = *(const u32x4*)(P + (size_t)row * 8960 + 4608 + branch * 1024 + c);
                    mw[m][bj] = (branch > 0) ? *(const u32x4*)(mb + (size_t)row * 1024 + c) : (u32x4){0u, 0u, 0u, 0u}; }
            __builtin_amdgcn_sched_barrier(0);
#pragma unroll
            for (int m = 0; m < 4; ++m) { const int row = row0 + ai * HALF + m * 16;
#pragma unroll
                for (int bj = 0; bj < 2; ++bj) { const int c = col0 + bj * HALF; const size_t off = (size_t)row * 1024 + c;
                    float x[8];
#pragma unroll
                    for (int j = 0; j < 4; ++j) { x[2 * j] = __builtin_bit_cast(float, gw[m][bj][j] << 16) * acc[ai][bj][m][j >> 1][2 * (j & 1)] + __builtin_bit_cast(float, mw[m][bj][j] << 16);
                        x[2 * j + 1] = __builtin_bit_cast(float, gw[m][bj][j] & 0xffff0000u) * acc[ai][bj][m][j >> 1][2 * (j & 1) + 1] + __builtin_bit_cast(float, mw[m][bj][j] & 0xffff0000u); }
                    u32x4 w; w.x = cvt_pk_bf16(x[0], x[1]); w.y = cvt_pk_bf16(x[2], x[3]); w.z = cvt_pk_bf16(x[4], x[5]); w.w = cvt_pk_bf16(x[6], x[7]);
                    *(u32x4*)(mb + off) = w; } }
        }
    }
};
struct EpiPlainM {
    static constexpr bool PERM = true, AFTER_DRAIN = false, RSTD = false;
    bf16_t* O; size_t ostride;
    __device__ __forceinline__ void operator()(const f32x4 (&acc)[2][2][4][2], const Unit& u, int wr, int wc, int fr, int fq) const {
        const int i = u.pn >> 2, pn = u.pn & 3, pm = u.pm - 65 * i; bf16_t* Ob = O + (size_t)i * ostride;
        const int row0 = pm * BM + wr * 64 + fr, col0 = pn * BM + wc * 32 + 8 * fq;
#pragma unroll
        for (int ai = 0; ai < 2; ++ai)
#pragma unroll
            for (int m = 0; m < 4; ++m) { const int row = row0 + ai * HALF + m * 16;
#pragma unroll
                for (int bj = 0; bj < 2; ++bj) { const f32x4 v0 = acc[ai][bj][m][0], v1 = acc[ai][bj][m][1];
                    u32x4 w; w.x = cvt_pk_bf16(v0[0], v0[1]); w.y = cvt_pk_bf16(v0[2], v0[3]); w.z = cvt_pk_bf16(v1[0], v1[1]); w.w = cvt_pk_bf16(v1[2], v1[3]);
                    *(u32x4*)(Ob + (size_t)row * 1024 + col0 + bj * HALF) = w; } }
    }
};
template <class Epi, class Sched, bool ALIGN_EPI = false, bool SP2 = false>
__device__ __forceinline__ void gemm_phase(PG8_LAS unsigned char* lds, const Gemm g, const Sched& S, const Epi& E, int tid_in) {
    int tid_ = tid_in; asm volatile("" : "+v"(tid_)); const int tid = tid_, wid = __builtin_amdgcn_readfirstlane(tid >> 6), lane = tid & 63, wr = wid >> 2, wc = wid & 3, fr = lane & 15, fq = lane >> 4;
    const int K = g.K, nt = K / BK;
    unsigned voffA[2], voffB[2];
#pragma unroll
    for (int i = 0; i < 2; ++i) { int R, C; stage_rc(tid * 16 + i * 8192, R, C); const int Rb = Epi::PERM ? ((R & ~31) + perm32(R & 31)) : R;
        voffA[i] = (unsigned)(R * g.lda + C) * 2u; voffB[i] = (unsigned)(Rb * K + C) * 2u; }
    const size_t kstep = (size_t)(BK * 2);
    const size_t hstepB = (size_t)HALF * K * 2, hstepA = (size_t)HALF * g.lda * 2;
    const size_t tstepA = 2 * hstepA, tstepB = 2 * hstepB;
    const unsigned ldsw = (unsigned)wid * 1024u;
    const int aoff = lds_byte(wr * 64 + fr, fq * 8), boff = lds_byte(wc * 32 + fr, fq * 8);
#define PG8_SA(b, h) (((b) * 2 + (h)) * HTB)
#define PG8_SB(b, h) ((4 + (b) * 2 + (h)) * HTB)
#define PG8_STAGE(bufoff, gbase, voff) do { _Pragma("unroll") for (int _i = 0; _i < 2; ++_i) \
        __builtin_amdgcn_global_load_lds((const unsigned*)((const char*)(gbase) + (voff)[_i]), (PG8_LAS unsigned*)(lds + (bufoff) + ldsw + _i * 8192), 16, 0, 0); } while (0)
#define PG8_LDA(dst, b, h) do { _Pragma("unroll") for (int m = 0; m < 4; ++m) _Pragma("unroll") for (int k = 0; k < 2; ++k) dst[m][k] = *(const PG8_LAS bf16x8*)(lds + PG8_SA(b, h) + aoff + m * 2048 + k * 1024); } while (0)
#define PG8_LDB(dst, b, h) do { _Pragma("unroll") for (int n = 0; n < 2; ++n) _Pragma("unroll") for (int k = 0; k < 2; ++k) dst[n][k] = *(const PG8_LAS bf16x8*)(lds + PG8_SB(b, h) + boff + n * 2048 + k * 1024); } while (0)
#define PG8_MMA(ai, bj, At, Bt) do { __builtin_amdgcn_s_setprio(1); _Pragma("unroll") for (int m = 0; m < 4; ++m) _Pragma("unroll") for (int n = 0; n < 2; ++n) _Pragma("unroll") for (int k = 0; k < 2; ++k) \
        acc[ai][bj][m][n] = __builtin_amdgcn_mfma_f32_16x16x32_bf16(Bt[n][k], At[m][k], acc[ai][bj][m][n], 0, 0, 0); __builtin_amdgcn_s_setprio(0); } while (0)
#define PG8_WAIT_V(n) asm volatile("s_waitcnt vmcnt(" #n ")" ::: "memory")
#define PG8_WAIT_L(n) asm volatile("s_waitcnt lgkmcnt(" #n ")" ::: "memory")
#define PG8_BAR __builtin_amdgcn_s_barrier()
#define PG8_SCHED __builtin_amdgcn_sched_barrier(0)
    Unit cur, nxt; int ui = 0;
    if (!S.next(0, cur)) return;
    f32x4 acc[2][2][4][2];
#pragma unroll
    for (int a = 0; a < 2; ++a)
#pragma unroll
        for (int b = 0; b < 2; ++b)
#pragma unroll
            for (int m = 0; m < 4; ++m)
#pragma unroll
                for (int n = 0; n < 2; ++n) acc[a][b][m][n] = (f32x4){0.f, 0.f, 0.f, 0.f};
    bf16x8 At[4][2], B0[2][2], B1[2][2];
    const char* cA = (const char*)g.A + (size_t)cur.pm * tstepA; const char* cB = (const char*)g.Bt + (size_t)cur.pn * tstepB;
    PG8_LAS float* rtab = (PG8_LAS float*)(lds + 131072 + 1024);
    if constexpr (Epi::RSTD) {
        Unit tu;
        for (int k = 0; S.next(k, tu); ++k)
            if (tid_in < 256) rtab[k * 256 + tid_in] = ep_rstd(E.ssq, tu.pm * BM + tid_in);
        __syncthreads();
    }
    S.a_ready(cur);
    if constexpr (SP2) {
        PG8_STAGE(PG8_SB(0, 0), cB, voffB); PG8_STAGE(PG8_SB(0, 1), cB + hstepB, voffB); PG8_STAGE(PG8_SA(0, 0), cA, voffA); PG8_STAGE(PG8_SA(0, 1), cA + hstepA, voffA);
        if (wr == 1) PG8_BAR;
        PG8_WAIT_V(2); PG8_BAR;
        PG8_STAGE(PG8_SB(1, 0), cB + kstep, voffB); PG8_STAGE(PG8_SA(1, 0), cA + kstep, voffA); PG8_STAGE(PG8_SB(1, 1), cB + hstepB + kstep, voffB);
        PG8_WAIT_V(6); PG8_BAR;
    } else {
        PG8_STAGE(PG8_SB(0, 0), cB, voffB); PG8_STAGE(PG8_SA(0, 0), cA, voffA); PG8_STAGE(PG8_SB(0, 1), cB + hstepB, voffB); PG8_STAGE(PG8_SA(0, 1), cA + hstepA, voffA);
        if (wr == 1) PG8_BAR;
        PG8_WAIT_V(4); PG8_BAR;
        PG8_STAGE(PG8_SB(1, 0), cB + kstep, voffB); PG8_STAGE(PG8_SA(1, 0), cA + kstep, voffA); PG8_STAGE(PG8_SB(1, 1), cB + hstepB + kstep, voffB);
        PG8_WAIT_V(6); PG8_BAR;
    }
    for (;;) {
        const bool has_next = S.next(ui + 1, nxt);
        const char* nA = has_next ? (const char*)g.A + (size_t)nxt.pm * tstepA : cA; const char* nB = has_next ? (const char*)g.Bt + (size_t)nxt.pn * tstepB : cB;
        for (int t = 0; t < nt; t += 2) {
            const bool last = (t == nt - 2);
            const char* a1 = cA + (size_t)(t + 1) * kstep;
            const char* a2 = last ? nA : cA + (size_t)(t + 2) * kstep; const char* b2 = last ? nB : cB + (size_t)(t + 2) * kstep;
            const char* a3 = a2 + kstep; const char* b3 = b2 + kstep;
            if (last && has_next) S.a_ready(nxt);
            if constexpr (SP2) {
            PG8_LDB(B0, 0, 0); PG8_LDB(B1, 0, 1); PG8_SCHED; PG8_LDA(At, 0, 0); PG8_STAGE(PG8_SA(1, 1), a1 + hstepA, voffA);
            PG8_WAIT_V(8); PG8_WAIT_L(0); PG8_BAR; PG8_MMA(0, 0, At, B0); PG8_MMA(0, 1, At, B1); PG8_BAR; PG8_SCHED;
            PG8_LDA(At, 0, 1); PG8_STAGE(PG8_SB(0, 0), b2, voffB); PG8_STAGE(PG8_SB(0, 1), b2 + hstepB, voffB); PG8_STAGE(PG8_SA(0, 0), a2, voffA);
            PG8_WAIT_V(8); PG8_WAIT_L(0); PG8_BAR; PG8_MMA(1, 0, At, B0); PG8_MMA(1, 1, At, B1); PG8_BAR; PG8_SCHED;
            PG8_LDB(B0, 1, 0); PG8_LDB(B1, 1, 1); PG8_SCHED; PG8_LDA(At, 1, 0); PG8_STAGE(PG8_SA(0, 1), a2 + hstepA, voffA);
            PG8_WAIT_V(8); PG8_WAIT_L(0); PG8_BAR; PG8_MMA(0, 0, At, B0); PG8_MMA(0, 1, At, B1); PG8_BAR; PG8_SCHED;
            PG8_LDA(At, 1, 1); PG8_STAGE(PG8_SB(1, 0), b3, voffB); PG8_STAGE(PG8_SB(1, 1), b3 + hstepB, voffB); PG8_STAGE(PG8_SA(1, 0), a3, voffA);
            PG8_WAIT_V(8); PG8_WAIT_L(0); PG8_BAR; PG8_MMA(1, 0, At, B0); PG8_MMA(1, 1, At, B1); PG8_BAR; PG8_SCHED;
            } else {
            PG8_LDB(B0, 0, 0); PG8_SCHED; PG8_LDA(At, 0, 0); PG8_STAGE(PG8_SA(1, 1), a1 + hstepA, voffA);
            PG8_WAIT_L(8); PG8_BAR; PG8_WAIT_L(0); PG8_MMA(0, 0, At, B0); PG8_BAR; PG8_SCHED;
            PG8_LDB(B1, 0, 1); PG8_STAGE(PG8_SB(0, 0), b2, voffB);
            PG8_BAR; PG8_WAIT_L(0); PG8_MMA(0, 1, At, B1); PG8_BAR;
            PG8_LDA(At, 0, 1); PG8_STAGE(PG8_SA(0, 0), a2, voffA);
            PG8_BAR; PG8_WAIT_L(0); PG8_MMA(1, 0, At, B0); PG8_BAR; PG8_SCHED;
            PG8_STAGE(PG8_SB(0, 1), b2 + hstepB, voffB);
            PG8_WAIT_V(6); PG8_BAR; PG8_MMA(1, 1, At, B1); PG8_BAR;
            PG8_LDB(B0, 1, 0); PG8_SCHED; PG8_LDA(At, 1, 0); PG8_STAGE(PG8_SA(0, 1), a2 + hstepA, voffA);
            PG8_WAIT_L(8); PG8_BAR; PG8_WAIT_L(0); PG8_MMA(0, 0, At, B0); PG8_BAR; PG8_SCHED;
            PG8_LDB(B1, 1, 1); PG8_STAGE(PG8_SB(1, 0), b3, voffB);
            PG8_BAR; PG8_WAIT_L(0); PG8_MMA(0, 1, At, B1); PG8_BAR;
            PG8_LDA(At, 1, 1); PG8_STAGE(PG8_SA(1, 0), a3, voffA);
            PG8_BAR; PG8_WAIT_L(0); PG8_MMA(1, 0, At, B0); PG8_BAR; PG8_SCHED;
            PG8_STAGE(PG8_SB(1, 1), b3 + hstepB, voffB);
            PG8_WAIT_V(6); PG8_BAR; PG8_MMA(1, 1, At, B1); PG8_BAR;
            }
        }
        if constexpr (ALIGN_EPI) { if (wr == 0) PG8_BAR; }
        if constexpr (Epi::RSTD) { float rsv[2][4];
            _Pragma("unroll") for (int ai = 0; ai < 2; ++ai) _Pragma("unroll") for (int m = 0; m < 4; ++m) rsv[ai][m] = rtab[ui * 256 + wr * 64 + fr + ai * 128 + m * 16];
            E(acc, cur, wr, wc, fr, fq, rsv); S.done(cur); }
        else if constexpr (!Epi::AFTER_DRAIN) { E(acc, cur, wr, wc, fr, fq); S.done(cur); }
        if (!has_next) break;
#pragma unroll
        for (int a = 0; a < 2; ++a)
#pragma unroll
            for (int b = 0; b < 2; ++b)
#pragma unroll
                for (int m = 0; m < 4; ++m)
#pragma unroll
                    for (int n = 0; n < 2; ++n) acc[a][b][m][n] = (f32x4){0.f, 0.f, 0.f, 0.f};
        cur = nxt; cA = nA; cB = nB; ++ui;
        if constexpr (ALIGN_EPI) { if (wr == 1) PG8_BAR; }
    }
    PG8_WAIT_V(0);
    if constexpr (!ALIGN_EPI) { if (wr == 0) PG8_BAR; }
    PG8_BAR;
    if constexpr (Epi::AFTER_DRAIN) { E.fused(acc, cur, wr, wc, fr, fq, lds, wid, lane); S.done(cur); }
#undef PG8_SA
#undef PG8_SB
#undef PG8_STAGE
#undef PG8_LDA
#undef PG8_LDB
#undef PG8_MMA
#undef PG8_WAIT_V
#undef PG8_WAIT_L
#undef PG8_BAR
#undef PG8_SCHED
}
}
#define XB_TMO      128
#define XB_XCNT(j)  (256  + 64 * (j))
#define XB_XSUB(j)  (1280 + 64 * (j))
#define XB_XGEN(j)  (2304 + 64 * (j))
#define XB_TOP      3328
#define XB_TOPGEN   3392
#define XCD_BAR_WORDS 3456
#define XB_SPIN_CAP (1u << 18)
#define LAS __attribute__((address_space(3)))

__device__ __forceinline__ unsigned xb_ld(unsigned* p)              { return __hip_atomic_load(p, __ATOMIC_RELAXED, __HIP_MEMORY_SCOPE_AGENT); }
__device__ __forceinline__ unsigned xb_add(unsigned* p, unsigned v) { return __hip_atomic_fetch_add(p, v, __ATOMIC_RELAXED, __HIP_MEMORY_SCOPE_AGENT); }
__device__ __forceinline__ unsigned xb_xcc_id() { return (unsigned)__builtin_amdgcn_s_getreg((3 << 11) | 20) & 0xFu; }
#define XB_SPIN(cond, bar) do { unsigned _sp = 0; while (cond) { __builtin_amdgcn_s_sleep(1); \
    if ((++_sp & 255u) == 0u) { if (xb_ld(&(bar)[XB_TMO])) break; if (_sp > XB_SPIN_CAP) { atomicAdd(&(bar)[XB_TMO], 1u); break; } } } } while (0)

__device__ __forceinline__ int xb_lane_id() { return (int)__builtin_amdgcn_mbcnt_hi(~0u, __builtin_amdgcn_mbcnt_lo(~0u, 0u)); }
struct XcdBarrier {
    int w0; unsigned* bar; unsigned x;
    volatile LAS unsigned* st;
};

__device__ __forceinline__ XcdBarrier xcd_barrier_post(unsigned* bar, volatile LAS unsigned* st, int w0) {
    XcdBarrier b; b.w0 = w0; b.bar = bar; b.x = xb_xcc_id(); b.st = st;
    if (b.w0 == 0 && xb_lane_id() == 0) (void)xb_add(&bar[XB_XCNT(b.x)], 1u);
    return b;
}
__device__ __forceinline__ void xcd_barrier_complete(unsigned* bar, unsigned x, unsigned& nloc, unsigned& nx) {
    const unsigned G = gridDim.x * gridDim.y * gridDim.z;
    unsigned sum, cnt, mine, sp = 0u;
    for (;;) {
        sum = 0u; cnt = 0u; mine = 0u;
#pragma unroll
        for (unsigned j = 0; j < 16; ++j) { const unsigned c = xb_ld(&bar[XB_XCNT(j)]); sum += c; cnt += (c > 0u) ? 1u : 0u; mine = (j == x) ? c : mine; }
        if (sum == G) break;
        __builtin_amdgcn_s_sleep(1);
        if ((++sp & 255u) == 0u) { if (xb_ld(&bar[XB_TMO])) break; if (sp > XB_SPIN_CAP) { atomicAdd(&bar[XB_TMO], 1u); break; } }
    }
    nloc = mine > 0u ? mine : 1u; nx = cnt > 0u ? cnt : 1u;
}

__device__ __forceinline__ void xcd_barrier(const XcdBarrier& b) {
    asm volatile("s_waitcnt vmcnt(0)" ::: "memory");
    __syncthreads();
    if (b.w0 == 0 && xb_lane_id() == 0) {
        unsigned* bar = b.bar;
        __builtin_amdgcn_s_waitcnt(0);
        unsigned nloc = b.st[0], nx = b.st[1];
        if (nloc == 0u) { xcd_barrier_complete(bar, b.x, nloc, nx); b.st[0] = nloc; b.st[1] = nx; }
        const unsigned old = xb_add(&bar[XB_XSUB(b.x)], 1u);
        const unsigned gen = old / nloc;
        if (old + 1u == (gen + 1u) * nloc) {
            __builtin_amdgcn_fence(__ATOMIC_RELEASE, "agent");
            asm volatile("s_waitcnt vmcnt(0)" ::: "memory");
            const unsigned og = xb_add(&bar[XB_TOP], 1u);
            const unsigned tg = og / nx;
            if (og + 1u == (tg + 1u) * nx) xb_add(&bar[XB_TOPGEN], 1u);
            else XB_SPIN(xb_ld(&bar[XB_TOPGEN]) == tg, bar);
            __builtin_amdgcn_fence(__ATOMIC_ACQUIRE, "agent");
            xb_add(&bar[XB_XGEN(b.x)], 1u);
            asm volatile("s_waitcnt vmcnt(0)" ::: "memory");
        } else {
            XB_SPIN(xb_ld(&bar[XB_XGEN(b.x)]) == gen, bar);
            __builtin_amdgcn_fence(__ATOMIC_ACQUIRE, "agent");
            asm volatile("s_waitcnt vmcnt(0)" ::: "memory");
        }
    }
    __syncthreads();
}

struct Args {
    const float* in[39]; const int* page_table; float* out; unsigned char* ws; int ph_lo, ph_hi;
};
struct Frame {
    LAS unsigned char* lds;
    int tid, lane, wave, G, bid, wave0;
    const float* const* in; const int* page_table; float* out; unsigned char* ws;
};
template <class T> __device__ __forceinline__ T* launder_ptr(T* p) {
    unsigned lo = (unsigned)(unsigned long long)p, hi = (unsigned)((unsigned long long)p >> 32); asm volatile("" : "+v"(lo), "+v"(hi));
    lo = __builtin_amdgcn_readfirstlane(lo); hi = __builtin_amdgcn_readfirstlane(hi); return (T*)(GAS T*)(((unsigned long long)hi << 32) | lo);
}
__device__ __forceinline__ int launder_int(int x) { asm volatile("" : "+v"(x)); return __builtin_amdgcn_readfirstlane(x); }
__device__ __forceinline__ void launder(Frame& F) {
    int t = F.wave0 * 64 + (int)__builtin_amdgcn_mbcnt_hi(~0u, __builtin_amdgcn_mbcnt_lo(~0u, 0u)); asm volatile("" : "+v"(t)); F.tid = t; F.lane = t & 63; F.wave = __builtin_amdgcn_readfirstlane(t >> 6);
    F.ws = launder_ptr(F.ws); F.out = launder_ptr(F.out); F.in = launder_ptr(F.in); F.page_table = launder_ptr(F.page_table);
    F.G = launder_int((int)gridDim.x); F.bid = launder_int((int)blockIdx.x);
}
#define LDS_WAIT() asm volatile("s_waitcnt lgkmcnt(0)" ::: "memory")
#define INP(k) ((const float*)(const GAS float*)(F.in[k]))
#define AIN(k) ((const float*)(const GAS float*)(args.in[k]))
template <class T> __device__ __forceinline__ T* wsp(const Frame& F, size_t off) { return (T*)(F.ws + off); }
__device__ __forceinline__ bf16* wl(const Frame& F, int L, size_t off) { return (bf16*)(F.ws + WS_W + (size_t)L * WL_SIZE + off); }
__device__ __forceinline__ float* ssqbuf(const Frame& F, int i) { return (float*)(F.ws + WS_SSQ) + (size_t)i * MT * 16; }

template <class CM>
__device__ __forceinline__ void transpose_item(const float* W, int K, int N, bf16* WT, const float* gain, LAS float* scr, int item, int lane, int ndst, CM cmap) {
    const int nblk = ndst / 32, kb = item / nblk, nb = item % nblk, k0 = 64 * kb, n0 = 32 * nb;
    const int sc = cmap(n0 + (lane & 31));
    {
        float v[32];
#pragma unroll
        for (int i = 0; i < 32; ++i) { const int kk = 2 * i + (lane >> 5); v[i] = (sc >= 0) ? W[(size_t)(k0 + kk) * N + sc] : 0.f; }
        if (gain) {
#pragma unroll
            for (int i = 0; i < 32; ++i) v[i] *= gain[k0 + 2 * i + (lane >> 5)]; }
#pragma unroll
        for (int i = 0; i < 32; ++i) scr[(2 * i + (lane >> 5)) * 33 + (lane & 31)] = v[i];
    }
    LDS_WAIT(); asm volatile("" ::: "memory");
    const int c = lane & 7;
#pragma unroll
    for (int j = 0; j < 4; ++j) { const int n = (lane >> 3) + 8 * j; const LAS float* s = scr + (8 * c) * 33 + n;
        v4u o; o.x = pk2(s[0 * 33], s[1 * 33]); o.y = pk2(s[2 * 33], s[3 * 33]); o.z = pk2(s[4 * 33], s[5 * 33]); o.w = pk2(s[6 * 33], s[7 * 33]);
        *(v4u*)(WT + (size_t)(n0 + n) * K + k0 + 8 * c) = o; }
    LDS_WAIT(); asm volatile("" ::: "memory");
}
struct CmId { __device__ int operator()(int n) const { return n; } };
struct CmGu { __device__ int operator()(int n) const { return ((n >> 7) & 1) * 2816 + (n >> 8) * 128 + (n & 127); } };
struct CmQb { __device__ int operator()(int n) const { return n < 768 ? n : -1; } };
struct CmIn { __device__ int operator()(int n) const { return n < 2048 ? n : (n < 4096 ? n + 8 : (n < 8704 ? n + 40 : (n < 8736 ? n - 4600 : (n < 8744 ? n - 6688 : -1)))); } };

#define W_ITEM(PTR, L, r_) do { int r = (r_); \
        if (r < I_GU) { transpose_item(PTR(12) + (size_t)(L) * 1024 * 5632, 1024, 5632, wl(F, L, WL_GU1), PTR(11) + (L) * 1024, scr, r, F.lane, 5632, CmGu()); break; } r -= I_GU; \
        if (r < I_GU) { transpose_item(PTR(37) + (size_t)(L) * 1024 * 5632, 1024, 5632, wl(F, L, WL_GU2), PTR(36) + (L) * 1024, scr, r, F.lane, 5632, CmGu()); break; } r -= I_GU; \
        if (r < I_D) { transpose_item(PTR(13) + (size_t)(L) * 2816 * 1024, 2816, 1024, wl(F, L, WL_D1), nullptr, scr, r, F.lane, 1024, CmId()); break; } r -= I_D; \
        if (r < I_D) { transpose_item(PTR(38) + (size_t)(L) * 2816 * 1024, 2816, 1024, wl(F, L, WL_D2), nullptr, scr, r, F.lane, 1024, CmId()); break; } r -= I_D; \
        if (r < I_IN) { transpose_item(PTR(15) + (size_t)(L) * 1024 * NIN, 1024, NIN, wl(F, L, WL_IN), PTR(14) + (L) * 1024, scr, r, F.lane, NINP, CmIn()); break; } r -= I_IN; \
        if (r < I_O4) { transpose_item(PTR(20) + (size_t)(L) * 512 * 1024, 512, 1024, wl(F, L, WL_DNO), nullptr, scr, r, F.lane, 1024, CmId()); break; } r -= I_O4; \
        if (r < I_O4) { transpose_item(PTR(22) + (size_t)(L) * 512 * 1024, 512, 1024, wl(F, L, WL_SCO), nullptr, scr, r, F.lane, 1024, CmId()); break; } r -= I_O4; \
        if (r < I_O4) { transpose_item(PTR(29) + (size_t)(L) * 512 * 1024, 512, 1024, wl(F, L, WL_MLAO), nullptr, scr, r, F.lane, 1024, CmId()); break; } r -= I_O4; \
        if (r < I_O4) { transpose_item(PTR(34) + (size_t)(L) * 512 * 1024, 512, 1024, wl(F, L, WL_MEMO), nullptr, scr, r, F.lane, 1024, CmId()); break; } r -= I_O4; \
        if (r < I_QB) { transpose_item(PTR(24) + (size_t)(L) * 256 * 768, 256, 768, wl(F, L, WL_QB), PTR(23) + (L) * 256, scr, r, F.lane, 1024, CmQb()); break; } r -= I_QB; \
        if (r < I_KVB) { transpose_item(PTR(26) + (size_t)(L) * 256 * 1024, 256, 1024, wl(F, L, WL_KVB), nullptr, scr, r, F.lane, 1024, CmId()); break; } r -= I_KVB; \
        if (r < I_WO) { transpose_item(PTR(35) + (size_t)(L) * 1024 * 1024, 1024, 1024, wl(F, L, WL_WO), nullptr, scr, r, F.lane, 1024, CmId()); break; } r -= I_WO; \
        transpose_item(PTR(31) + (size_t)(L) * 1024 * 1024, 1024, 1024, wsp<bf16>(F, WS_WMEMKV) + (size_t)(L) * 1024 * 1024, PTR(30) + (L) * 1024, scr, r, F.lane, 1024, CmId()); } while (0)
constexpr int I_GU = 16 * 176, I_D = 44 * 32, I_IN = 16 * 280, I_O4 = 8 * 32, I_QB = 4 * 32, I_KVB = 4 * 32, I_WO = 16 * 32, I_MKV = 16 * 32;
constexpr int PER_L = 2 * I_GU + 2 * I_D + I_IN + 4 * I_O4 + I_QB + I_KVB + I_WO + I_MKV, PER_L1 = PER_L - I_MKV;
__device__ __forceinline__ void p0_weights(Frame& F, const Args& args, bool defer1) {
    LAS float* scr = (LAS float*)(F.lds + F.wave * 16384);
    const int gw = F.bid * NWAVES + F.wave, NGW = F.G * NWAVES;
    const int total = defer1 ? PER_L + I_MKV : 2 * PER_L;
    for (int it = gw; it < total; it += NGW) {
        if (it < PER_L) W_ITEM(AIN, 0, it);
        else if (defer1) W_ITEM(AIN, 1, PER_L1 + (it - PER_L));
        else W_ITEM(AIN, 1, it - PER_L);
    }
}
__device__ __forceinline__ void w1_fill(Frame& F, int vb, int vG, int i0, int i1) {
    LAS float* scr = (LAS float*)(F.lds + F.wave * 16384);
    for (int it = i0 + vb * NWAVES + F.wave; it < i1; it += vG * NWAVES) W_ITEM(INP, 1, it);
}
__device__ const float ROPE_INV[16] = {1.0f, 0.562341332f, 0.316227764f, 0.177827939f, 0.100000001f, 0.0562341325f, 0.0316227749f, 0.0177827943f, 0.00999999978f, 0.00562341325f, 0.00316227763f, 0.00177827943f, 0.00100000005f, 0.000562341302f, 0.000316227757f, 0.00017782794f};
__device__ __forceinline__ void p0_rows(Frame& F, const Args& args) {
    const int gw = F.bid * NWAVES + F.wave, NGW = F.G * NWAVES, lane = F.lane;
    float* X = wsp<float>(F, WS_X); bf16* XB = wsp<bf16>(F, WS_XB); float* ssq0 = ssqbuf(F, 0);
    for (int m = gw; m < MT; m += NGW) {
        f32x4 v[4]; float s = 0.f;
        const float* src = m < MP ? AIN(0) + (size_t)m * D : (m < MV ? AIN(1) + (size_t)(m - MP) * D : nullptr);
#pragma unroll
        for (int j = 0; j < 4; ++j) { v[j] = src ? *(const f32x4*)(src + 4 * lane + 256 * j) : (f32x4){0.f, 0.f, 0.f, 0.f}; s += (v[j][0] * v[j][0] + v[j][1] * v[j][1]) + (v[j][2] * v[j][2] + v[j][3] * v[j][3]); }
        s = wave_sum(s);
#pragma unroll
        for (int j = 0; j < 4; ++j) { *(f32x4*)(X + (size_t)m * D + 4 * lane + 256 * j) = v[j]; v2u w; w.x = pk2(v[j][0], v[j][1]); w.y = pk2(v[j][2], v[j][3]); *(v2u*)(XB + (size_t)m * D + 4 * lane + 256 * j) = w; }
        if (lane < 16) ssq0[(size_t)m * 16 + lane] = lane == 0 ? s : 0.f;
    }
    bf16* MEMB = wsp<bf16>(F, WS_MEMB);
    for (int m = gw; m < 2048; m += NGW) {
        f32x4 v[4]; float s = 0.f; const float* src = AIN(10) + (size_t)m * D;
#pragma unroll
        for (int j = 0; j < 4; ++j) { v[j] = *(const f32x4*)(src + 4 * lane + 256 * j); s += (v[j][0] * v[j][0] + v[j][1] * v[j][1]) + (v[j][2] * v[j][2] + v[j][3] * v[j][3]); }
        s = wave_sum(s); const float rs = rsq_f(s * (1.0f / 1024.0f) + EPS);
#pragma unroll
        for (int j = 0; j < 4; ++j) { v2u w; w.x = pk2(v[j][0] * rs, v[j][1] * rs); w.y = pk2(v[j][2] * rs, v[j][3] * rs); *(v2u*)(MEMB + (size_t)m * D + 4 * lane + 256 * j) = w; }
    }
    float* rope = wsp<float>(F, WS_ROPE);
    for (int i = F.bid * 512 + F.tid; i < 2052 * 16; i += F.G * 512) {
        const int p = i >> 4, k = i & 15; const int pos = p < 2048 ? p : 16384 + (p - 2048);
        const float ang = (float)pos * ROPE_INV[k];
        rope[p * 32 + k] = cosf(ang); rope[p * 32 + 16 + k] = sinf(ang);
    }
    bf16* MK = wsp<bf16>(F, WS_MK); bf16* MVT = wsp<bf16>(F, WS_MVT);
    for (int i = F.bid * 512 + F.tid; i < 2 * 32 * 256 * 4 * 16; i += F.G * 512) {
        const int c8 = i & 15, h = (i >> 4) & 3, m = (i >> 6) & 255, db = (i >> 14) & 31, l = i >> 19;
        const float* src = AIN(7) + ((((size_t)l * 32 + db) * 256 + m) * 4 + h) * 128 + c8 * 8;
        const f32x4 a = *(const f32x4*)src, b = *(const f32x4*)(src + 4);
        v4u w; w.x = pk2(a[0], a[1]); w.y = pk2(a[2], a[3]); w.z = pk2(b[0], b[1]); w.w = pk2(b[2], b[3]);
        *(v4u*)(MK + ((((size_t)l * NSEQ + 8 + db) * 4 + h) * 256 + m) * 128 + c8 * 8) = w;
    }
    for (int i = F.bid * 512 + F.tid; i < 2 * 32 * 4 * 128 * 32; i += F.G * 512) {
        const int d = i & 127, m8 = (i >> 7) & 31, h = (i >> 12) & 3, db = (i >> 14) & 31, l = i >> 19;
        float f[8];
#pragma unroll
        for (int j = 0; j < 8; ++j) f[j] = AIN(8)[((((size_t)l * 32 + db) * 256 + m8 * 8 + j) * 4 + h) * 128 + d];
        *(v4u*)(MVT + ((((size_t)l * NSEQ + 8 + db) * 4 + h) * 128 + d) * 256 + m8 * 8) = pack8(f);
    }
}
__device__ __forceinline__ void p2_memkv_post(Frame& F, int vb, int vG) {
    const int gw = vb * NWAVES + F.wave, NGW = vG * NWAVES, lane = F.lane;
    bf16* MK = wsp<bf16>(F, WS_MK); bf16* MVT = wsp<bf16>(F, WS_MVT);
    for (int r = gw; r < 2 * 2048; r += NGW) {
        const int l = r >> 11, bm = r & 2047, b = bm >> 8, m = bm & 255, h = lane >> 4, c = (lane & 15) * 8;
        float* kp = F.out + O_PMK + (size_t)r * 512 + lane * 8;
        f32x4 a = *(const f32x4*)kp, bb = *(const f32x4*)(kp + 4);
        float s = (a[0] * a[0] + a[1] * a[1]) + (a[2] * a[2] + a[3] * a[3]) + (bb[0] * bb[0] + bb[1] * bb[1]) + (bb[2] * bb[2] + bb[3] * bb[3]);
        s = sum16(s); const float rs = rsq_f(s * (1.0f / 128.0f) + EPS);
        const float* gn = INP(33) + l * 128 + c;
        float f[8];
#pragma unroll
        for (int j = 0; j < 4; ++j) { f[j] = a[j] * rs * gn[j]; f[4 + j] = bb[j] * rs * gn[4 + j]; }
        *(f32x4*)kp = (f32x4){f[0], f[1], f[2], f[3]}; *(f32x4*)(kp + 4) = (f32x4){f[4], f[5], f[6], f[7]};
        *(v4u*)(MK + ((((size_t)l * NSEQ + b) * 4 + h) * 256 + m) * 128 + c) = pack8(f);
    }
    for (int i = vb * 512 + F.tid; i < 2 * 8 * 4 * 128 * 32; i += vG * 512) {
        const int d = i & 127, m8 = (i >> 7) & 31, h = (i >> 12) & 3, b = (i >> 14) & 7, l = i >> 17;
        float f[8];
#pragma unroll
        for (int j = 0; j < 8; ++j) f[j] = F.out[O_PMV + (((size_t)l * 8 + b) * 256 + m8 * 8 + j) * 512 + h * 128 + d];
        *(v4u*)(MVT + ((((size_t)l * NSEQ + b) * 4 + h) * 128 + d) * 256 + m8 * 8) = pack8(f);
    }
}

#define PREP_STAGE3() do { \
        _Pragma("unroll") for (int r = 0; r < 4; ++r) { mq[r] = *(const v2u*)(P0 + (size_t)r * NINP + PC_MQ + 4 * lane); mk[r] = *(const v2u*)(P0 + (size_t)r * NINP + PC_MKV + 4 * lane); mm[r] = *(const v4u*)(P0 + (size_t)r * NINP + PC_MEMQ + 8 * lane); } \
        { const int r = lane >> 4, kk = lane & 15; const size_t row = row0 + r; const int pp = smp ? 2048 + t0 + r : t0 + r; \
          rx1 = SIDE[row * 64 + kk]; rx2 = SIDE[row * 64 + 16 + kk]; rcs = rope[pp * 32 + kk]; rsn = rope[pp * 32 + 16 + kk]; } } while (0)
__device__ __forceinline__ void prep_rows(Frame& F, int L) {
    const int gw = F.bid * NWAVES + F.wave, NGW = F.G * NWAVES, lane = F.lane;
    const bf16* P = wsp<bf16>(F, WS_P); const float* SIDE = wsp<float>(F, WS_SIDE);
    bf16* QKVN = wsp<bf16>(F, WS_QKVN); float* GB = wsp<float>(F, WS_GB); bf16* OSC = wsp<bf16>(F, WS_OSC);
    bf16* CQB = wsp<bf16>(F, WS_CQB); bf16* CKVB = wsp<bf16>(F, WS_CKVB); float* KRB = wsp<float>(F, WS_KRB); bf16* QMB = wsp<bf16>(F, WS_QMB);
    const float* rope = wsp<float>(F, WS_ROPE);
    const float* dnw = INP(16) + (size_t)L * 4 * 1536; const float* scw = INP(21) + (size_t)L * 3 * 512;
    for (int wi = gw; wi < MP / 4 + 7 * (MS / 4); wi += NGW) {
        const int sidx = wi - MP / 4; const int grp = sidx < 0 ? wi : MP / 4 + sidx / 7; const int mask = sidx < 0 ? 0x7F : 1 << (sidx % 7);
        const int row0 = grp * 4; const bool smp = row0 >= MP; const int sq = smp ? (row0 - MP) >> 2 : row0 >> 11; const int t0 = smp ? 0 : row0 & 2047; const int T = smp ? 4 : 2048;
        const bf16* P0 = P + (size_t)row0 * NINP;
        const bool hist = t0 > 0;
        v2u mq[4], mk[4]; v4u mm[4]; float rx1, rx2, rcs, rsn;
#pragma unroll 1
        for (int i = 0; i < 3; ++i) {
            if (!((mask >> i) & 1)) continue;
            const int c = 512 * i + 8 * lane; float x[7][8], wv[4][8];
#pragma unroll
            for (int k = 0; k < 7; ++k) {
                if (k >= 3 || t0 > 0) unpack8(*(const v4u*)(P0 + (ptrdiff_t)(k - 3) * NINP + c), x[k]);
                else if (smp) { const float* pv = INP(3) + (((size_t)L * 32 + sq) * 3 + k) * 1536 + c; const f32x4 a = *(const f32x4*)pv, bq = *(const f32x4*)(pv + 4);
#pragma unroll
                    for (int j = 0; j < 4; ++j) { x[k][j] = a[j]; x[k][4 + j] = bq[j]; } }
                else {
#pragma unroll
                    for (int j = 0; j < 8; ++j) x[k][j] = 0.f; }
            }
#pragma unroll
            for (int jj = 0; jj < 4; ++jj) { const f32x4 wa = *(const f32x4*)(dnw + jj * 1536 + c), wb = *(const f32x4*)(dnw + jj * 1536 + c + 4);
#pragma unroll
                for (int j = 0; j < 4; ++j) { wv[jj][j] = wa[j]; wv[jj][4 + j] = wb[j]; } }
#pragma unroll
            for (int r = 0; r < 4; ++r) {
                float acc[8];
#pragma unroll
                for (int j = 0; j < 8; ++j) acc[j] = (x[r][j] * wv[0][j] + x[r + 1][j] * wv[1][j]) + (x[r + 2][j] * wv[2][j] + x[r + 3][j] * wv[3][j]);
                if (t0 + r >= T - 3) {
                    float* o = F.out + (smp ? O_SDNC + (((size_t)L * 32 + sq) * 3 + (t0 + r - (T - 3))) * 1536 : O_PDNC + (((size_t)L * 8 + sq) * 3 + (t0 + r - (T - 3))) * 1536) + c;
                    *(f32x4*)o = (f32x4){x[r + 3][0], x[r + 3][1], x[r + 3][2], x[r + 3][3]}; *(f32x4*)(o + 4) = (f32x4){x[r + 3][4], x[r + 3][5], x[r + 3][6], x[r + 3][7]};
                }
                float ss = 0.f;
#pragma unroll
                for (int j = 0; j < 8; ++j) { acc[j] = silu_f(acc[j]); ss += acc[j] * acc[j]; }
                if (i < 2) { ss = sum16(ss); const float rs = rsq_f(ss + EPS);
#pragma unroll
                    for (int j = 0; j < 8; ++j) acc[j] *= rs; }
                *(v4u*)(QKVN + (size_t)(row0 + r) * 1536 + c) = pack8(acc);
            }
        }
        if ((mask & 8) && lane < 16) { const int r = lane >> 2, hh = lane & 3; const size_t row = row0 + r; const float a = SIDE[row * 64 + 32 + hh], bq = SIDE[row * 64 + 36 + hh];
            const float xs = a + INP(18)[L * 4 + hh]; const float ex = fexp2(xs * LOG2E);
            const float sp = xs > 15.f ? xs : (ex < 1e-4f ? ex * (1.0f - 0.5f * ex) : __log2f(1.0f + ex) * 0.6931471805599453f);
            GB[row * 8 + hh] = -fexp2(INP(17)[L * 4 + hh] * LOG2E) * sp; GB[row * 8 + 4 + hh] = sigmoid_f(bq); }
        if (mask & 16) {
            const int c = 8 * lane; float u[6][8], wv[3][8], bv[4][8];
#pragma unroll
            for (int k = 0; k < 6; ++k) {
                if (k >= 2 || t0 > 0) { float cv[8], xv[8]; unpack8(*(const v4u*)(P0 + (ptrdiff_t)(k - 2) * NINP + PC_SCC + c), cv); unpack8(*(const v4u*)(P0 + (ptrdiff_t)(k - 2) * NINP + PC_SCX + c), xv);
#pragma unroll
                    for (int j = 0; j < 8; ++j) u[k][j] = cv[j] * xv[j]; }
                else if (smp) { const float* pv = INP(4) + (((size_t)L * 32 + sq) * 2 + k) * 512 + c; const f32x4 a = *(const f32x4*)pv, bq = *(const f32x4*)(pv + 4);
#pragma unroll
                    for (int j = 0; j < 4; ++j) { u[k][j] = a[j]; u[k][4 + j] = bq[j]; } }
                else {
#pragma unroll
                    for (int j = 0; j < 8; ++j) u[k][j] = 0.f; }
            }
#pragma unroll
            for (int r = 0; r < 4; ++r) unpack8(*(const v4u*)(P0 + (size_t)r * NINP + PC_SCB + c), bv[r]);
            if (mask & 0x60) PREP_STAGE3();
#pragma unroll
            for (int jj = 0; jj < 3; ++jj) { const f32x4 wa = *(const f32x4*)(scw + jj * 512 + c), wb = *(const f32x4*)(scw + jj * 512 + c + 4);
#pragma unroll
                for (int j = 0; j < 4; ++j) { wv[jj][j] = wa[j]; wv[jj][4 + j] = wb[j]; } }
#pragma unroll
            for (int r = 0; r < 4; ++r) {
                float acc[8];
#pragma unroll
                for (int j = 0; j < 8; ++j) acc[j] = ((u[r][j] * wv[0][j] + u[r + 1][j] * wv[1][j]) + u[r + 2][j] * wv[2][j]) * bv[r][j];
                if (t0 + r >= T - 2) {
                    float* o = F.out + (smp ? O_SSCC + (((size_t)L * 32 + sq) * 2 + (t0 + r - (T - 2))) * 512 : O_PSCC + (((size_t)L * 8 + sq) * 2 + (t0 + r - (T - 2))) * 512) + c;
                    *(f32x4*)o = (f32x4){u[r + 2][0], u[r + 2][1], u[r + 2][2], u[r + 2][3]}; *(f32x4*)(o + 4) = (f32x4){u[r + 2][4], u[r + 2][5], u[r + 2][6], u[r + 2][7]};
                }
                *(v4u*)(OSC + (size_t)(row0 + r) * 512 + c) = pack8(acc);
            }
        }
        else if (mask & 0x60) PREP_STAGE3();
        if (mask & 32) {
            const int c = 4 * lane; float q[4][4], k[4][4], sq2[4], sk2[4];
#pragma unroll
            for (int r = 0; r < 4; ++r) { const v2u qw = mq[r], kw = mk[r];
                q[r][0] = bflo(qw.x); q[r][1] = bfhi(qw.x); q[r][2] = bflo(qw.y); q[r][3] = bfhi(qw.y); k[r][0] = bflo(kw.x); k[r][1] = bfhi(kw.x); k[r][2] = bflo(kw.y); k[r][3] = bfhi(kw.y);
                sq2[r] = (q[r][0] * q[r][0] + q[r][1] * q[r][1]) + (q[r][2] * q[r][2] + q[r][3] * q[r][3]); sk2[r] = (k[r][0] * k[r][0] + k[r][1] * k[r][1]) + (k[r][2] * k[r][2] + k[r][3] * k[r][3]); }
#pragma unroll
            for (int r = 0; r < 4; ++r) { sq2[r] = wave_sum(sq2[r]); sk2[r] = wave_sum(sk2[r]); }
            const f32x4 gn = *(const f32x4*)(INP(25) + L * 256 + c);
#pragma unroll
            for (int r = 0; r < 4; ++r) { const size_t row = row0 + r; const int t = t0 + r;
                const float rq = rsq_f(sq2[r] * (1.0f / 256.0f) + EPS), rk = rsq_f(sk2[r] * (1.0f / 256.0f) + EPS);
                v2u w; w.x = pk2(q[r][0] * rq, q[r][1] * rq); w.y = pk2(q[r][2] * rq, q[r][3] * rq); *(v2u*)(CQB + row * 256 + c) = w;
                f32x4 ck;
#pragma unroll
                for (int j = 0; j < 4; ++j) ck[j] = k[r][j] * rk * gn[j];
                float* o = F.out + (smp ? O_SCKV + (((size_t)L * 32 + sq) * 4 + t) * 256 : O_PCKV + (((size_t)L * 8 + sq) * 2048 + t) * 256) + c;
                *(f32x4*)o = ck; w.x = pk2(ck[0], ck[1]); w.y = pk2(ck[2], ck[3]); *(v2u*)(CKVB + row * 256 + c) = w; }
            { const int r = lane >> 4, kk = lane & 15; const size_t row = row0 + r; const int t = t0 + r;
              const float x1 = rx1, x2 = rx2, cs = rcs, sn = rsn;
              const float o1 = x1 * cs - x2 * sn, o2 = x2 * cs + x1 * sn;
              KRB[row * 32 + kk] = o1; KRB[row * 32 + 16 + kk] = o2;
              float* ok = F.out + (smp ? O_SKR + (((size_t)L * 32 + sq) * 4 + t) * 32 : O_PKR + (((size_t)L * 8 + sq) * 2048 + t) * 32);
              ok[kk] = o1; ok[16 + kk] = o2; }
        }
        if (mask & 64) {
            const int c = 8 * lane; float q[4][8], ss[4]; const float* gn = INP(32) + L * 128 + (c & 127);
#pragma unroll
            for (int r = 0; r < 4; ++r) { unpack8(mm[r], q[r]); ss[r] = 0.f;
#pragma unroll
                for (int j = 0; j < 8; ++j) ss[r] += q[r][j] * q[r][j]; }
#pragma unroll
            for (int r = 0; r < 4; ++r) ss[r] = sum16(ss[r]);
#pragma unroll
            for (int r = 0; r < 4; ++r) { const float rs = (rsq_f(ss[r] * (1.0f / 128.0f) + EPS)) * (0.08838834764831845f * LOG2E);
#pragma unroll
                for (int j = 0; j < 8; ++j) q[r][j] *= rs * gn[j];
                *(v4u*)(QMB + (size_t)(row0 + r) * 512 + c) = pack8(q[r]); }
        }
    }
}
#undef PREP_STAGE3

__device__ __forceinline__ void mla_post_rows(Frame& F, int L, int row0, bool smp, LAS bf16* Vl, int trow) {
    const bf16* QRAW = wsp<bf16>(F, WS_QRAW); const bf16* KVRAW = wsp<bf16>(F, WS_KVRAW); const float* KRB = wsp<float>(F, WS_KRB); const float* rope = wsp<float>(F, WS_ROPE);
    bf16* QF = wsp<bf16>(F, WS_QF); bf16* QSG = wsp<bf16>(F, WS_QSG); bf16* KF = wsp<bf16>(F, WS_KF); bf16* KFS = wsp<bf16>(F, WS_KFS);
    const float* qn = INP(27) + L * 96; const float* kn = INP(28) + L * 96;
    const float qscale = 0.10206207261596575f * LOG2E;
    const int lane = F.lane, r = lane >> 4, h = (lane >> 1) & 7, hf = lane & 1;
    const int row = row0 + r; const int t = smp ? (row - MP) & 3 : row & 2047; const int pp = smp ? 2048 + t : t;
    const bf16* qp = QRAW + (size_t)row * 1024 + h * 96;
    float q[6][8];
#pragma unroll
    for (int j = 0; j < 4; ++j) unpack8(*(const v4u*)(qp + 8 * (4 * hf + j)), q[j]);
    unpack8(*(const v4u*)(qp + 8 * (8 + hf)), q[4]); unpack8(*(const v4u*)(qp + 8 * (10 + hf)), q[5]);
    float ss = 0.f;
#pragma unroll
    for (int j = 0; j < 6; ++j)
#pragma unroll
        for (int e = 0; e < 8; ++e) ss += q[j][e] * q[j][e];
    ss += dppf<0xB1>(ss);
    const float rq = (rsq_f(ss * (1.0f / 96.0f) + EPS)) * qscale;
#pragma unroll
    for (int e = 0; e < 8; ++e) { const float cs = rope[pp * 32 + 8 * hf + e], sn = rope[pp * 32 + 16 + 8 * hf + e]; const float x1 = q[4][e], x2 = q[5][e]; q[4][e] = x1 * cs - x2 * sn; q[5][e] = x2 * cs + x1 * sn; }
    bf16* qo = QF + (size_t)row * 768 + h * 96; bf16* qs = QSG + (size_t)(smp ? row - MP : 0) * 768 + h * 96;
#pragma unroll
    for (int j = 0; j < 6; ++j) { const int ch = j < 4 ? 4 * hf + j : (j == 4 ? 8 + hf : 10 + hf);
#pragma unroll
        for (int e = 0; e < 8; ++e) q[j][e] *= rq * qn[8 * ch + e];
        *(v4u*)(qo + 8 * ch) = pack8(q[j]);
        if (smp) {
#pragma unroll
            for (int e = 0; e < 8; ++e) q[j][e] *= kn[8 * ch + e];
            *(v4u*)(qs + 8 * ch) = pack8(q[j]); } }
    const bf16* kp = KVRAW + (size_t)row * 1024 + h * 128; const float* krp = KRB + (size_t)row * 32 + 16 * hf;
    float k[6][8];
#pragma unroll
    for (int j = 0; j < 4; ++j) unpack8(*(const v4u*)(kp + 8 * (4 * hf + j)), k[j]);
#pragma unroll
    for (int j = 0; j < 2; ++j) { const f32x4 ra = *(const f32x4*)(krp + 8 * j), rb = *(const f32x4*)(krp + 8 * j + 4);
#pragma unroll
        for (int e = 0; e < 4; ++e) { k[4 + j][e] = ra[e]; k[4 + j][4 + e] = rb[e]; } }
    float sk = 0.f;
#pragma unroll
    for (int j = 0; j < 6; ++j)
#pragma unroll
        for (int e = 0; e < 8; ++e) sk += k[j][e] * k[j][e];
    sk += dppf<0xB1>(sk);
    const float rk = rsq_f(sk * (1.0f / 96.0f) + EPS);
    bf16* ko = smp ? KFS + (size_t)(row - MP) * 768 + h * 96 : KF + ((size_t)((row >> 11) * 8 + h) * 2048 + t) * 96;
#pragma unroll
    for (int j = 0; j < 6; ++j) { const int c0 = j < 4 ? 8 * (4 * hf + j) : 64 + 16 * hf + 8 * (j - 4);
#pragma unroll
        for (int e = 0; e < 8; ++e) k[j][e] *= rk * kn[c0 + e];
        *(v4u*)(ko + c0) = pack8(k[j]); }
    if (!smp) {
#pragma unroll
        for (int j = 0; j < 4; ++j) *(LAS v4u*)(Vl + (trow + r) * 520 + h * 64 + 8 * (4 * hf + j)) = *(const v4u*)(kp + 64 + 8 * (4 * hf + j)); }
}
__device__ __forceinline__ void mla_post(Frame& F, int L) {
    LAS bf16* Vl = (LAS bf16*)F.lds;
    bf16* VT = wsp<bf16>(F, WS_VT);
    for (int u = F.bid; u < 256; u += F.G) {
        const int row0 = u * 64;
        __syncthreads();
#pragma unroll 1
        for (int it = 0; it < 2; ++it) mla_post_rows(F, L, row0 + 32 * it + 4 * F.wave, false, Vl, 32 * it + 4 * F.wave);
        __syncthreads();
        {
            const int col = F.tid, b = row0 >> 11, t0 = row0 & 2047; bf16* vo = VT + ((size_t)((b * 8 + (col >> 6)) * 64 + (col & 63))) * 2048 + t0;
#pragma unroll
            for (int j = 0; j < 8; ++j) { v4u w; unsigned short e[8];
#pragma unroll
                for (int x = 0; x < 8; ++x) e[x] = Vl[(8 * j + x) * 520 + col];
                w.x = e[0] | ((unsigned)e[1] << 16); w.y = e[2] | ((unsigned)e[3] << 16); w.z = e[4] | ((unsigned)e[5] << 16); w.w = e[6] | ((unsigned)e[7] << 16);
                *(v4u*)(vo + 8 * j) = w; }
        }
    }
    for (int gidx = F.bid * NWAVES + F.wave; gidx < 32; gidx += F.G * NWAVES) mla_post_rows(F, L, MP + 4 * gidx, true, Vl, 0);
}

template <int DQK, int DV> struct AttnCfg { static constexpr int KCH = 64 * (DQK / 8), NKR = (KCH + 511) / 512, NVR = (DV * 8) / 512, NS = DQK / 32; };
template <int DQK, int DV, bool CAUSAL>
__device__ __forceinline__ void attn_unit(Frame& F, const bf16* Q, int qpitch, int nq, int q0, const bf16* K, int kpitch, const bf16* Vt, int vtpitch, int nkeys, bf16* O, int opitch,
                                          v4u (&kreg)[AttnCfg<DQK, DV>::NKR], v4u (&vreg)[AttnCfg<DQK, DV>::NVR], bf16x8 (&bq)[AttnCfg<DQK, DV>::NS], bool prefetched,
                                          const bf16* Qn, int nqn, const bf16* Kn, const bf16* Vtn, bool has_next) {
    constexpr int KP = DQK + 8, VP = 64 + 8, NS = DQK / 32, ND = DV / 16;
    LAS bf16* Ks = (LAS bf16*)F.lds; LAS bf16* Vts = (LAS bf16*)(F.lds + 64 * KP * 2);
    const int lane = F.lane, w = F.wave, lq = lane & 15, g = lane >> 4, qrow = 16 * w + lq;
    if (!prefetched) {
#pragma unroll
        for (int s = 0; s < NS; ++s) { if (qrow < nq) bq[s] = *(const bf16x8*)(Q + (size_t)qrow * qpitch + 32 * s + 8 * g); else bq[s] = (bf16x8){0, 0, 0, 0, 0, 0, 0, 0}; }
    }
    bf16x8 bqn[NS];
    f32x4 o[ND];
#pragma unroll
    for (int d = 0; d < ND; ++d) o[d] = (f32x4){0.f, 0.f, 0.f, 0.f};
    float m_run = -1e30f, l_run = 0.f;
    const int ntiles = CAUSAL ? (q0 + nq + 63) / 64 : nkeys / 64;
    const int mylast = CAUSAL ? (q0 + 16 * w + 15) / 64 : ntiles - 1;
    constexpr int KCH = AttnCfg<DQK, DV>::KCH, NKR = AttnCfg<DQK, DV>::NKR, NVR = AttnCfg<DQK, DV>::NVR;
#define ATT_FETCH(K_, Vt_, kt_) do { const int k0_ = (kt_) * 64; \
        _Pragma("unroll") for (int i_ = 0; i_ < NKR; ++i_) { const int idx = F.tid + 512 * i_; if (idx < KCH) kreg[i_] = *(const v4u*)((K_) + (size_t)(k0_ + idx / (DQK / 8)) * kpitch + (idx % (DQK / 8)) * 8); } \
        _Pragma("unroll") for (int i_ = 0; i_ < NVR; ++i_) { const int idx = F.tid + 512 * i_; vreg[i_] = *(const v4u*)((Vt_) + (size_t)(idx >> 3) * vtpitch + k0_ + (idx & 7) * 8); } } while (0)
    if (!prefetched) ATT_FETCH(K, Vt, 0);
    for (int kt = 0; kt < ntiles; ++kt) {
        const int k0 = kt * 64;
        __syncthreads();
#pragma unroll
        for (int i_ = 0; i_ < NKR; ++i_) { const int idx = F.tid + 512 * i_; if (idx < KCH) *(LAS v4u*)(Ks + (idx / (DQK / 8)) * KP + (idx % (DQK / 8)) * 8) = kreg[i_]; }
#pragma unroll
        for (int i_ = 0; i_ < NVR; ++i_) { const int idx = F.tid + 512 * i_; *(LAS v4u*)(Vts + (idx >> 3) * VP + (idx & 7) * 8) = vreg[i_]; }
        __syncthreads();
        if (kt + 1 < ntiles) ATT_FETCH(K, Vt, kt + 1);
        else if (has_next) { ATT_FETCH(Kn, Vtn, 0);
#pragma unroll
            for (int s = 0; s < NS; ++s) { if (qrow < nqn) bqn[s] = *(const bf16x8*)(Qn + (size_t)qrow * qpitch + 32 * s + 8 * g); else bqn[s] = (bf16x8){0, 0, 0, 0, 0, 0, 0, 0}; } }
        if (kt <= mylast) {
            f32x4 s[4];
            {   bf16x8 ka[4][NS];
#pragma unroll
                for (int kk = 0; kk < 4; ++kk)
#pragma unroll
                    for (int ss = 0; ss < NS; ++ss) ka[kk][ss] = *(const LAS bf16x8*)(Ks + (16 * kk + lq) * KP + 32 * ss + 8 * g);
                __builtin_amdgcn_sched_barrier(0);
#pragma unroll
                for (int kk = 0; kk < 4; ++kk) s[kk] = (f32x4){0.f, 0.f, 0.f, 0.f};
#pragma unroll
                for (int ss = 0; ss < NS; ++ss)
#pragma unroll
                    for (int kk = 0; kk < 4; ++kk) s[kk] = __builtin_amdgcn_mfma_f32_16x16x32_bf16(ka[kk][ss], bq[ss], s[kk], 0, 0, 0);
            }
            if (CAUSAL && k0 + 63 > q0 + 16 * w) {
#pragma unroll
                for (int kk = 0; kk < 4; ++kk)
#pragma unroll
                    for (int r = 0; r < 4; ++r) if (k0 + 16 * kk + 4 * g + r > q0 + qrow) s[kk][r] = -1e30f;
            }
            float mx = -1e30f;
#pragma unroll
            for (int kk = 0; kk < 4; ++kk) mx = fmaxf(fmaxf(fmaxf(s[kk][0], s[kk][1]), fmaxf(s[kk][2], s[kk][3])), mx);
            mx = xrow_max(mx);
            const float m_new = fmaxf(m_run, mx), alpha = fexp2(m_run - m_new); m_run = m_new;
            float ls = 0.f;
#pragma unroll
            for (int kk = 0; kk < 4; ++kk)
#pragma unroll
                for (int r = 0; r < 4; ++r) { s[kk][r] = fexp2(s[kk][r] - m_new); ls += s[kk][r]; }
            l_run = l_run * alpha + ls;
#pragma unroll
            for (int d = 0; d < ND; ++d) o[d] *= alpha;
#pragma unroll
            for (int u = 0; u < 2; ++u) {
                v4u pw; pw.x = pk2(s[2 * u][0], s[2 * u][1]); pw.y = pk2(s[2 * u][2], s[2 * u][3]); pw.z = pk2(s[2 * u + 1][0], s[2 * u + 1][1]); pw.w = pk2(s[2 * u + 1][2], s[2 * u + 1][3]);
                const bf16x8 bp = __builtin_bit_cast(bf16x8, pw);
                bf16x8 va[ND];
#pragma unroll
                for (int d = 0; d < ND; ++d) {
                    const v2u lo = *(const LAS v2u*)(Vts + (16 * d + lq) * VP + 32 * u + 4 * g), hi = *(const LAS v2u*)(Vts + (16 * d + lq) * VP + 32 * u + 16 + 4 * g);
                    v4u aw; aw.x = lo.x; aw.y = lo.y; aw.z = hi.x; aw.w = hi.y; va[d] = __builtin_bit_cast(bf16x8, aw); }
                __builtin_amdgcn_sched_barrier(0);
#pragma unroll
                for (int d = 0; d < ND; ++d) o[d] = __builtin_amdgcn_mfma_f32_16x16x32_bf16(va[d], bp, o[d], 0, 0, 0);
            }
        }
    }
#undef ATT_FETCH
    float lt = xrow_sum(l_run);
    const float inv = 1.0f / lt;
    if (qrow < nq) {
#pragma unroll
        for (int d = 0; d < ND; ++d) { v2u wv; wv.x = pk2(o[d][0] * inv, o[d][1] * inv); wv.y = pk2(o[d][2] * inv, o[d][3] * inv); *(v2u*)(O + (size_t)qrow * opitch + 16 * d + 4 * g) = wv; }
    }
    if (has_next) {
#pragma unroll
        for (int s = 0; s < NS; ++s) bq[s] = bqn[s]; }
}
__device__ __forceinline__ void mla_prompt_attn(Frame& F) {
    const bf16* QF = wsp<bf16>(F, WS_QF); const bf16* KF = wsp<bf16>(F, WS_KF); const bf16* VT = wsp<bf16>(F, WS_VT); bf16* OMLA = wsp<bf16>(F, WS_OMLA);
    const bool skip32 = F.G > 64; const int G2 = skip32 ? F.G - 32 : F.G, b2 = skip32 ? F.bid - 32 : F.bid;
    if (b2 < 0) return;
    v4u kreg[AttnCfg<96, 64>::NKR], vreg[AttnCfg<96, 64>::NVR]; bf16x8 bq[AttnCfg<96, 64>::NS]; bool pf = false;
    for (int rr = 0; ; ++rr) {
        const int u = rr * G2 + ((rr & 1) ? G2 - 1 - b2 : b2); if (u >= 1024) break;
        const int qb = 15 - (u >> 6), bh = u & 63;
        const int b = bh >> 3, h = bh & 7;
        const int un = (rr + 1) * G2 + (((rr + 1) & 1) ? G2 - 1 - b2 : b2); const bool hn = un < 1024;
        const int qbn = 15 - ((hn ? un : u) >> 6), bhn = (hn ? un : u) & 63, bn = bhn >> 3, hnn = bhn & 7;
        attn_unit<96, 64, true>(F, QF + ((size_t)(b * 2048 + 128 * qb) * 8 + h) * 96, 768, 128, 128 * qb, KF + (size_t)(bh * 2048) * 96, 96, VT + (size_t)(bh * 64) * 2048, 2048, 2048,
                                OMLA + (size_t)(b * 2048 + 128 * qb) * 512 + h * 64, 512, kreg, vreg, bq, pf,
                                QF + ((size_t)(bn * 2048 + 128 * qbn) * 8 + hnn) * 96, 128, KF + (size_t)(bhn * 2048) * 96, VT + (size_t)(bhn * 64) * 2048, hn);
        pf = hn;
    }
}
__device__ __forceinline__ void mem_attn(Frame& F, int L) {
    const bf16* QMB = wsp<bf16>(F, WS_QMB); const bf16* MK = wsp<bf16>(F, WS_MK); const bf16* MVT = wsp<bf16>(F, WS_MVT); bf16* OMEM = wsp<bf16>(F, WS_OMEM);
    const bool skip32 = F.G > 64;
    const int G2 = skip32 ? F.G - 32 : F.G, b2 = skip32 ? F.bid - 32 : F.bid;
    if (b2 < 0) return;
    v4u kreg[AttnCfg<128, 128>::NKR], vreg[AttnCfg<128, 128>::NVR]; bf16x8 bq[AttnCfg<128, 128>::NS]; bool pf = false;
#define MEM_UNIT(u_, sq_, h_, row0_, nq_) do { if ((u_) < 512) { sq_ = (u_) >> 6; h_ = ((u_) >> 4) & 3; row0_ = sq_ * 2048 + ((u_) & 15) * 128; nq_ = 128; } \
        else { const int v_ = (u_) - 512; sq_ = 8 + (v_ >> 2); h_ = v_ & 3; row0_ = MP + (v_ >> 2) * 4; nq_ = 4; } } while (0)
    for (int u = b2; u < 512 + 128; u += G2) {
        int sq, h, row0, nq; MEM_UNIT(u, sq, h, row0, nq);
        const bool hn = u + G2 < 512 + 128; const int un = hn ? u + G2 : u;
        int sqn, hnn, row0n, nqn; MEM_UNIT(un, sqn, hnn, row0n, nqn);
        const size_t kvo = (((size_t)L * NSEQ + sq) * 4 + h) * 256 * 128, kvon = (((size_t)L * NSEQ + sqn) * 4 + hnn) * 256 * 128;
        attn_unit<128, 128, false>(F, QMB + (size_t)row0 * 512 + h * 128, 512, nq, 0, MK + kvo, 128, MVT + kvo, 256, 256, OMEM + (size_t)row0 * 512 + h * 128, 512, kreg, vreg, bq, pf,
                                   QMB + (size_t)row0n * 512 + hnn * 128, nqn, MK + kvon, MVT + kvon, hn);
        pf = hn;
    }
#undef MEM_UNIT
}
typedef short v4i16_t __attribute__((ext_vector_type(4)));
__device__ __forceinline__ void wuk_swizzle(Frame& F, int L) {
    const bf16* W = wl(F, L, WL_KVB); bf16* dst = wsp<bf16>(F, WS_WUKS) + (size_t)L * 131072;
    for (int t = F.bid * (NWAVES * 64) + F.tid; t < 16384; t += F.G * (NWAVES * 64)) {
        const int ln = t & 63, dt = (t >> 6) & 3, ks = (t >> 8) & 7, h = t >> 11;
        *(v4u*)(dst + (size_t)t * 8) = *(const v4u*)(W + (size_t)(h * 128 + 16 * dt + (ln & 15)) * 256 + 32 * ks + 8 * (ln >> 4));
    }
}
__device__ __forceinline__ void mla_sample_attn(Frame& F, int L) {
    constexpr int CP = 264, KRP = 40, PP = 72, SP = 68;
    LAS float* STC = (LAS float*)F.lds;
    LAS float* STR = (LAS float*)(F.lds + 65536);
    LAS bf16* Cs = (LAS bf16*)(F.lds + 73728);
    LAS bf16* KRs = (LAS bf16*)(F.lds + 107520);
    LAS bf16* Ps = (LAS bf16*)(F.lds + 112640);
    LAS float* KRSS = (LAS float*)(F.lds + 117248);
    LAS float* ALs = (LAS float*)(F.lds + 117504);
    LAS float* Ss = (LAS float*)(F.lds + 117632);
    LAS bf16* Qs = (LAS bf16*)(F.lds + 132096);
    const int lane = F.lane, w = F.wave, lq = lane & 15, g = lane >> 4, h = w;
    const bf16* QSG = wsp<bf16>(F, WS_QSG); const bf16* Wuks = wsp<bf16>(F, WS_WUKS) + (size_t)L * 131072;
    float* PART = wsp<float>(F, WS_PART); float* ML = wsp<float>(F, WS_ML);
    const GAS float* cache_c = (const GAS float*)(F.in[5]) + (size_t)L * NPHYS * 128 * 256; const GAS float* cache_r = (const GAS float*)(F.in[6]) + (size_t)L * NPHYS * 128 * 32;
    const int nst = 8 * ((1024 - F.bid + F.G - 1) / F.G);
#define MLS_PGID(dst_, s_) do { const int* pa_ = F.page_table + (((F.bid + ((s_) >> 3) * F.G) >> 5) * 128 + ((F.bid + ((s_) >> 3) * F.G) & 31) * 4 + (((s_) >> 1) & 3)); \
        asm volatile("s_load_dword %0, %1, 0x0\n\ts_waitcnt lgkmcnt(0)" : "=s"(dst_) : "s"(pa_) : "memory"); } while (0)
#define MLS_DMA(s_, ph_) do { const GAS float* cp_ = cache_c + ((size_t)(ph_) * 128 + ((s_) & 1) * 64) * 256; const GAS float* rp_ = cache_r + ((size_t)(ph_) * 128 + ((s_) & 1) * 64) * 32; \
        _Pragma("unroll") for (int it = 0; it < 8; ++it) __builtin_amdgcn_global_load_lds((const unsigned*)(const float*)(cp_ + (size_t)(w + 8 * it) * 256 + 4 * lane), (LAS unsigned*)(STC + (w + 8 * it) * 256), 16, 0, 0); \
        __builtin_amdgcn_global_load_lds((const unsigned*)(const float*)(rp_ + (size_t)w * 256 + 4 * lane), (LAS unsigned*)(STR + w * 256), 16, 0, 0); } while (0)
#define MLS_CONVERT() do { \
        _Pragma("unroll") for (int hb = 0; hb < 2; ++hb) { f32x4 cv_[4]; \
            _Pragma("unroll") for (int it = 0; it < 4; ++it) { const int idx = F.tid + 512 * (4 * hb + it), row = idx >> 6, c4 = idx & 63; cv_[it] = *(const LAS f32x4*)(STC + row * 256 + c4 * 4); } \
            __builtin_amdgcn_sched_barrier(0); \
            _Pragma("unroll") for (int it = 0; it < 4; ++it) { const int idx = F.tid + 512 * (4 * hb + it), row = idx >> 6, c4 = idx & 63; const f32x4 v = cv_[it]; \
                v2u wv; wv.x = pk2(v[0], v[1]); wv.y = pk2(v[2], v[3]); *(LAS v2u*)(Cs + row * CP + c4 * 4) = wv; } \
            __builtin_amdgcn_sched_barrier(0); } \
        { const int row = F.tid >> 3, c4 = F.tid & 7; const f32x4 v = *(const LAS f32x4*)(STR + row * 32 + c4 * 4); \
            v2u wv; wv.x = pk2(v[0], v[1]); wv.y = pk2(v[2], v[3]); *(LAS v2u*)(KRs + row * KRP + c4 * 4) = wv; \
            float s8 = (bflo(wv.x) * bflo(wv.x) + bfhi(wv.x) * bfhi(wv.x)) + (bflo(wv.y) * bflo(wv.y) + bfhi(wv.y) * bfhi(wv.y)); \
            s8 = row8_sum(s8); \
            if (c4 == 0) KRSS[row] = s8; } } while (0)
#define MLS_QSTAGE(ui_) do { if (F.tid < 384) { const int u_ = F.bid + (ui_) * F.G, db_ = u_ >> 5, r_ = F.tid / 12, c_ = F.tid % 12, q_ = r_ >> 3, h_ = r_ & 7; \
        *(LAS v4u*)(Qs + ((ui_) & 1) * 3072 + (h_ * 4 + q_) * 96 + 8 * c_) = *(const v4u*)(QSG + ((size_t)(db_ * 4 + q_) * 8 + h_) * 96 + 8 * c_); } } while (0)
    __syncthreads();
    bf16x8 wr[8][4];
#pragma unroll
    for (int ks = 0; ks < 8; ++ks)
#pragma unroll
        for (int dt = 0; dt < 4; ++dt) wr[ks][dt] = *(const bf16x8*)(Wuks + ((size_t)(((h * 8 + ks) * 4 + dt) * 64 + lane)) * 8);
    MLS_QSTAGE(0);
    { int ph0; MLS_PGID(ph0, 0); MLS_DMA(0, ph0); }
    asm volatile("s_waitcnt vmcnt(0)" ::: "memory");
    __syncthreads();
    MLS_CONVERT();
    __syncthreads();
    { const int s1 = 1 < nst ? 1 : 0; int ph1; MLS_PGID(ph1, s1); MLS_DMA(s1, ph1); }
    f32x4 pc[2][2]; float m_run = -1e30f, l_run = 0.f;
#pragma unroll
    for (int a_ = 0; a_ < 2; ++a_)
#pragma unroll
        for (int b_ = 0; b_ < 2; ++b_) pc[a_][b_] = (f32x4){0.f, 0.f, 0.f, 0.f};
#pragma unroll 1
    for (int i = 0; i < nst; ++i) {
        const int ui = i >> 3, u = F.bid + ui * F.G, j = i & 7, db = u >> 5, grp = u & 31;
        const int sn = i + 2 < nst ? i + 2 : nst - 1;
        int ph; MLS_PGID(ph, sn);
        if (j == 0) {
#pragma unroll
            for (int a_ = 0; a_ < 2; ++a_)
#pragma unroll
                for (int b_ = 0; b_ < 2; ++b_) pc[a_][b_] = (f32x4){0.f, 0.f, 0.f, 0.f};
            m_run = -1e30f; l_run = 0.f;
        }
        bf16x8 b[4];
#pragma unroll
        for (int ks = 0; ks < 2; ++ks) b[ks] = *(const LAS bf16x8*)(Cs + lq * CP + 8 * g + 32 * ks);
#pragma unroll 1
        for (int kk = 0; kk < 4; ++kk) {
            f32x4 acc[4];
#pragma unroll
            for (int dt = 0; dt < 4; ++dt) acc[dt] = (f32x4){0.f, 0.f, 0.f, 0.f};
            const LAS bf16* cb = Cs + (16 * kk + lq) * CP + 8 * g;
            const LAS bf16* cn = Cs + (16 * ((kk + 1) & 3) + lq) * CP + 8 * g;
#pragma unroll
            for (int ks = 2; ks < 4; ++ks) b[ks] = *(const LAS bf16x8*)(cb + 32 * ks);
            __builtin_amdgcn_sched_barrier(0);
#pragma unroll
            for (int ks = 0; ks < 8; ++ks) {
#pragma unroll
                for (int dt = 0; dt < 4; ++dt) acc[dt] = __builtin_amdgcn_mfma_f32_16x16x32_bf16(wr[ks][dt], b[ks & 3], acc[dt], 0, 0, 0);
                if (ks < 4) b[ks & 3] = *(const LAS bf16x8*)(cb + 32 * (ks + 4));
                else if (ks < 6) b[ks & 3] = *(const LAS bf16x8*)(cn + 32 * (ks - 4));
                __builtin_amdgcn_sched_barrier(0);
            }
            bf16x8 aq[2], aqr;
            {
            const LAS bf16* qp = Qs + (ui & 1) * 3072 + (h * 4 + (lq & 3)) * 96; const bool ok = lq < 4;
#pragma unroll
            for (int s = 0; s < 2; ++s) { v2u lo = *(const LAS v2u*)(qp + 32 * s + 4 * g), hi = *(const LAS v2u*)(qp + 32 * s + 16 + 4 * g); v4u t; t.x = ok ? lo.x : 0u; t.y = ok ? lo.y : 0u; t.z = ok ? hi.x : 0u; t.w = ok ? hi.y : 0u; aq[s] = __builtin_bit_cast(bf16x8, t); }
            v4u t = *(const LAS v4u*)(qp + 64 + 8 * g); if (!ok) { t.x = 0u; t.y = 0u; t.z = 0u; t.w = 0u; } aqr = __builtin_bit_cast(bf16x8, t);
            }
            {
                float ss = 0.f;
#pragma unroll
                for (int dt = 0; dt < 4; ++dt) ss += (acc[dt][0] * acc[dt][0] + acc[dt][1] * acc[dt][1]) + (acc[dt][2] * acc[dt][2] + acc[dt][3] * acc[dt][3]);
                ss = xrow_sum(ss);
                const float rstd = rsq_f((ss + KRSS[16 * kk + lq]) * (1.0f / 96.0f) + EPS);
                f32x4 sa = (f32x4){0.f, 0.f, 0.f, 0.f};
#pragma unroll
                for (int s2 = 0; s2 < 2; ++s2) { v4u bw; bw.x = pk2(acc[2 * s2][0], acc[2 * s2][1]); bw.y = pk2(acc[2 * s2][2], acc[2 * s2][3]); bw.z = pk2(acc[2 * s2 + 1][0], acc[2 * s2 + 1][1]); bw.w = pk2(acc[2 * s2 + 1][2], acc[2 * s2 + 1][3]);
                    sa = __builtin_amdgcn_mfma_f32_16x16x32_bf16(aq[s2], __builtin_bit_cast(bf16x8, bw), sa, 0, 0, 0); }
                const bf16x8 bkr = *(const LAS bf16x8*)(KRs + (16 * kk + lq) * KRP + 8 * g);
                sa = __builtin_amdgcn_mfma_f32_16x16x32_bf16(aqr, bkr, sa, 0, 0, 0);
                if (g == 0) {
#pragma unroll
                    for (int r = 0; r < 4; ++r) Ss[(h * 4 + r) * SP + 16 * kk + lq] = sa[r] * rstd; }
            }
        }
        LDS_WAIT(); asm volatile("" ::: "memory");
        {
            float sc[4];
#pragma unroll
            for (int kt = 0; kt < 4; ++kt) sc[kt] = Ss[(h * 4 + g) * SP + 16 * kt + lq];
            float mx = fmaxf(fmaxf(sc[0], sc[1]), fmaxf(sc[2], sc[3]));
            mx = max16(mx);
            const float m_new = fmaxf(m_run, mx), alpha = fexp2(m_run - m_new); m_run = m_new;
            float ls = 0.f;
#pragma unroll
            for (int kt = 0; kt < 4; ++kt) { sc[kt] = fexp2(sc[kt] - m_new); ls += sc[kt]; Ps[(h * 4 + g) * PP + 16 * kt + lq] = (bf16)f2bf(sc[kt]); }
            l_run = l_run * alpha + ls;
            if (lq == 0) ALs[h * 4 + g] = alpha;
        }
        LDS_WAIT(); asm volatile("" ::: "memory"); __builtin_amdgcn_s_barrier(); asm volatile("" ::: "memory");
#pragma unroll
        for (int rt = 0; rt < 2; ++rt)
#pragma unroll
            for (int r = 0; r < 4; ++r) { const float al = ALs[16 * rt + 4 * g + r]; pc[rt][0][r] *= al; pc[rt][1][r] *= al; }
#pragma unroll
        for (int ks = 0; ks < 2; ++ks) {
            bf16x8 pa[2];
#pragma unroll
            for (int rt = 0; rt < 2; ++rt) pa[rt] = *(const LAS bf16x8*)(Ps + (16 * rt + lq) * PP + 32 * ks + 8 * g);
#pragma unroll
            for (int ct = 0; ct < 2; ++ct) {
                const int c = 2 * w + ct, qq = lq >> 2, pp = lq & 3;
                const v4i16_t t0 = __builtin_amdgcn_ds_read_tr16_b64_v4i16((LAS v4i16_t*)(Cs + (32 * ks + 8 * g + qq) * CP + 16 * c + 4 * pp));
                const v4i16_t t1 = __builtin_amdgcn_ds_read_tr16_b64_v4i16((LAS v4i16_t*)(Cs + (32 * ks + 8 * g + 4 + qq) * CP + 16 * c + 4 * pp));
                const bf16x8 bc = (bf16x8){t0[0], t0[1], t0[2], t0[3], t1[0], t1[1], t1[2], t1[3]};
#pragma unroll
                for (int rt = 0; rt < 2; ++rt) pc[rt][ct] = __builtin_amdgcn_mfma_f32_16x16x32_bf16(pa[rt], bc, pc[rt][ct], 0, 0, 0);
            }
        }
        if (j == 7) {
#pragma unroll
            for (int rt = 0; rt < 2; ++rt)
#pragma unroll
                for (int ct = 0; ct < 2; ++ct)
#pragma unroll
                    for (int r = 0; r < 4; ++r) PART[((size_t)(db * 32 + grp) * 32 + 16 * rt + 4 * g + r) * 256 + 16 * (2 * w + ct) + lq] = pc[rt][ct][r];
            { float lt = sum16(l_run);
                if (lq == 0) { ML[((size_t)(db * 32 + grp) * 32 + h * 4 + g) * 2] = m_run; ML[((size_t)(db * 32 + grp) * 32 + h * 4 + g) * 2 + 1] = lt; } }
        }
        asm volatile("s_waitcnt vmcnt(0)" ::: "memory");
        __syncthreads();
        MLS_CONVERT();
        if (j == 7 && i + 1 < nst) MLS_QSTAGE(ui + 1);
        __syncthreads();
        MLS_DMA(sn, ph);
    }
    asm volatile("s_waitcnt vmcnt(0)" ::: "memory");
    __syncthreads();
#undef MLS_PGID
#undef MLS_DMA
#undef MLS_CONVERT
#undef MLS_QSTAGE
}
__device__ __forceinline__ void mla_sample_combine(Frame& F, int L) {
    const int gw = F.bid * NWAVES + F.wave, NGW = F.G * NWAVES, lane = F.lane;
    LAS float* pcs = (LAS float*)(F.lds + F.wave * 1024);
    const float* PART = wsp<float>(F, WS_PART); const float* ML = wsp<float>(F, WS_ML);
    const bf16* QF = wsp<bf16>(F, WS_QF); const bf16* KFS = wsp<bf16>(F, WS_KFS); bf16* OMLA = wsp<bf16>(F, WS_OMLA);
    const float* wkv = INP(26) + (size_t)L * 256 * 1024;
    for (int it = gw; it < 1024; it += NGW) {
        const int db = it >> 5, hq = it & 31, h = hq >> 2, q = hq & 3;
        float mg = -1e30f, lg = 0.f;
        if (lane < 32) { mg = ML[((size_t)(db * 32 + lane) * 32 + hq) * 2]; lg = ML[((size_t)(db * 32 + lane) * 32 + hq) * 2 + 1]; }
        float M = mg;
        M = xrow_max(max16(M));
        float sn[4];
        const bf16* qp = QF + ((size_t)(MP + db * 4 + q) * 8 + h) * 96;
#pragma unroll
        for (int j = 0; j < 4; ++j) { const bf16* kp = KFS + ((size_t)(db * 4 + j) * 8 + h) * 96; float s = bf2f(qp[lane]) * bf2f(kp[lane]); if (lane < 32) s += bf2f(qp[64 + lane]) * bf2f(kp[64 + lane]);
            sn[j] = wave_sum(s); if (j <= q) M = fmaxf(M, sn[j]); }
        const float wg = fexp2(mg - M);
        float lt = wave_sum(wg * lg);
        f32x4 pc = (f32x4){0.f, 0.f, 0.f, 0.f};
        for (int grp = 0; grp < 32; ++grp) { const float wgt = __shfl(wg, grp); pc += *(const f32x4*)(PART + ((size_t)(db * 32 + grp) * 32 + hq) * 256 + 4 * lane) * wgt; }
#pragma unroll
        for (int j = 0; j < 4; ++j) if (j <= q) { const float pj = fexp2(sn[j] - M); lt += pj; pc += *(const f32x4*)(F.out + O_SCKV + (((size_t)L * 32 + db) * 4 + j) * 256 + 4 * lane) * pj; }
        const float inv = 1.0f / lt;
        *(LAS f32x4*)(pcs + 4 * lane) = pc * inv;
        LDS_WAIT(); asm volatile("" ::: "memory");
        float o = 0.f;
#pragma unroll 8
        for (int r = 0; r < 256; ++r) o += pcs[r] * wkv[(size_t)r * 1024 + h * 128 + 64 + lane];
        OMLA[(size_t)(MP + db * 4 + q) * 512 + h * 64 + lane] = (bf16)f2bf(o);
        LDS_WAIT(); asm volatile("" ::: "memory");
    }
}

__device__ __forceinline__ void dn_seq(Frame& F, int L) {
    LAS bf16* Kq = (LAS bf16*)F.lds; LAS bf16* Qq = (LAS bf16*)(F.lds + 4096); LAS float* Vv = (LAS float*)(F.lds + 8192);
    LAS float* Gg = (LAS float*)(F.lds + 9216); LAS float* Bb = (LAS float*)(F.lds + 9280); LAS float* KQ = (LAS float*)(F.lds + 9344);
    const bf16* QKVN = wsp<bf16>(F, WS_QKVN); const float* GB = wsp<float>(F, WS_GB); float* ORAW = wsp<float>(F, WS_ORAW);
    const int lane = F.lane, e = 2 * F.wave + (lane >> 5), dg = lane & 31;
    const int GS = F.G >= 32 ? (F.G & ~31) : F.G;
    for (int base = F.bid; base < 1024 && F.bid < GS; base += 4 * GS) {
        const int h = (base >> 3) & 3, sl = base & 7, col = h * 128 + sl * 16 + e;
        float S[4][4];
#pragma unroll
        for (int j = 0; j < 4; ++j) { const int v = base + j * GS; const int sq = (v < 1024 ? v : base) >> 5;
#pragma unroll
            for (int i = 0; i < 4; ++i) S[j][i] = INP(2)[((((size_t)L * 32 + sq) * 4 + h) * 128 + 4 * dg + i) * 128 + sl * 16 + e]; }
        __syncthreads();
        {
            const int t = F.tid & 255, j = t >> 6, r = (t >> 4) & 3, c = t & 15; const int v = base + j * GS; const int sq = (v < 1024 ? v : base) >> 5; const size_t row = MP + sq * 4 + r;
            if (F.tid < 256) { const bf16* src = QKVN + row * 1536 + h * 128 + c * 8; *(LAS v4u*)(Qq + (j * 4 + r) * 128 + c * 8) = *(const v4u*)src; *(LAS v4u*)(Kq + (j * 4 + r) * 128 + c * 8) = *(const v4u*)(src + 512); }
            else Vv[(j * 4 + r) * 16 + c] = bf2f(QKVN[row * 1536 + 1024 + h * 128 + sl * 16 + c]);
            if (F.tid < 16) { const int j2 = F.tid >> 2, r2 = F.tid & 3; const int v2 = base + j2 * GS; const int sq2 = (v2 < 1024 ? v2 : base) >> 5; const size_t row2 = MP + sq2 * 4 + r2;
                Gg[F.tid] = expf(GB[row2 * 8 + h]); Bb[F.tid] = GB[row2 * 8 + 4 + h]; }
        }
        __syncthreads();
        if (F.tid < 16) { float s = 0.f;
            for (int jj = 0; jj < 16; ++jj) { float a[8], b[8]; unpack8(*(const LAS v4u*)(Kq + F.tid * 128 + 8 * jj), a); unpack8(*(const LAS v4u*)(Qq + F.tid * 128 + 8 * jj), b);
#pragma unroll
                for (int x = 0; x < 8; ++x) s += a[x] * b[x]; }
            KQ[F.tid] = s; }
        __syncthreads();
#pragma unroll
        for (int tt = 0; tt < 4; ++tt) {
#pragma unroll
            for (int j = 0; j < 4; ++j) {
                const v2u kw = *(const LAS v2u*)(Kq + (j * 4 + tt) * 128 + 4 * dg), qw = *(const LAS v2u*)(Qq + (j * 4 + tt) * 128 + 4 * dg);
                const float k0 = bflo(kw.x), k1 = bfhi(kw.x), k2 = bflo(kw.y), k3 = bfhi(kw.y), q0 = bflo(qw.x), q1 = bfhi(qw.x), q2 = bflo(qw.y), q3 = bfhi(qw.y);
                float pk = (k0 * S[j][0] + k1 * S[j][1]) + (k2 * S[j][2] + k3 * S[j][3]), pq = (q0 * S[j][0] + q1 * S[j][1]) + (q2 * S[j][2] + q3 * S[j][3]);
                pk = xsum16(sum16(pk)); pq = xsum16(sum16(pq));
                const float eg = Gg[j * 4 + tt], be = Bb[j * 4 + tt], vv = Vv[(j * 4 + tt) * 16 + e], kq = KQ[j * 4 + tt];
                const float delta = be * (vv - eg * pk);
                const float o = (eg * pq + delta * kq) * 0.08838834764831845f;
                S[j][0] = eg * S[j][0] + k0 * delta; S[j][1] = eg * S[j][1] + k1 * delta; S[j][2] = eg * S[j][2] + k2 * delta; S[j][3] = eg * S[j][3] + k3 * delta;
                const int v = base + j * GS;
                if (dg == 0 && v < 1024) ORAW[(size_t)(MP + (v >> 5) * 4 + tt) * 512 + col] = o;
            }
        }
#pragma unroll
        for (int j = 0; j < 4; ++j) { const int v = base + j * GS;
            if (v < 1024) { float* so = F.out + O_SDNS + (((size_t)L * 32 + (v >> 5)) * 4 + h) * 128 * 128;
#pragma unroll
                for (int i = 0; i < 4; ++i) so[(size_t)(4 * dg + i) * 128 + sl * 16 + e] = S[j][i]; } }
    }
}
__device__ __forceinline__ void dn_post(Frame& F, int L) {
    const int gw = F.bid * NWAVES + F.wave, NGW = F.G * NWAVES, lane = F.lane;
    const float* ORAW = wsp<float>(F, WS_ORAW); const bf16* P = wsp<bf16>(F, WS_P); bf16* ODN = wsp<bf16>(F, WS_ODN);
    const int c = 8 * lane; const float* gn = INP(19) + L * 128 + (c & 127);
    f32x4 an, bn; v4u zn;
    const bool split = NGW >= 2048; const int first = !split ? gw : (gw < 1024 ? gw : 2048 + (gw - 1024)), stride = !split ? NGW : (gw < 1024 ? 1024 : NGW - 1024), lim = !split ? MV : (gw < 1024 ? 2048 : MV);
    if (first < lim) { an = *(const f32x4*)(ORAW + (size_t)first * 512 + c); bn = *(const f32x4*)(ORAW + (size_t)first * 512 + c + 4); zn = *(const v4u*)(P + (size_t)first * NINP + PC_Z + c); }
    for (int row = first; row < lim; row += stride) {
        const f32x4 a = an, b = bn; const v4u zr = zn;
        { const int rn = row + stride < lim ? row + stride : row;
          an = *(const f32x4*)(ORAW + (size_t)rn * 512 + c); bn = *(const f32x4*)(ORAW + (size_t)rn * 512 + c + 4); zn = *(const v4u*)(P + (size_t)rn * NINP + PC_Z + c); }
        float x[8] = {a[0], a[1], a[2], a[3], b[0], b[1], b[2], b[3]}; float ss = 0.f;
#pragma unroll
        for (int j = 0; j < 8; ++j) ss += x[j] * x[j];
        ss = sum16(ss); const float rs = rsq_f(ss * (1.0f / 128.0f) + EPS);
        float z[8]; unpack8(zr, z);
#pragma unroll
        for (int j = 0; j < 8; ++j) x[j] = x[j] * rs * gn[j] * silu_f(z[j]);
        *(v4u*)(ODN + (size_t)row * 512 + c) = pack8(x);
    }
}
constexpr size_t DNC_U = 0;
constexpr size_t DNC_W = DNC_U + (size_t)1024 * 64 * 128 * 4;
constexpr size_t DNC_QG = DNC_W + (size_t)1024 * 64 * 128 * 2;
constexpr size_t DNC_KT = DNC_QG + (size_t)1024 * 64 * 128 * 2;
constexpr size_t DNC_AQK = DNC_KT + (size_t)1024 * 64 * 128 * 2;
constexpr size_t DNC_GL = DNC_AQK + (size_t)1024 * 64 * 64 * 2;
constexpr size_t DNC_SIZE = DNC_GL + 1024 * 4;
static_assert(DNC_SIZE <= WS_DNC_BYTES, "DN chunk scratch");

__device__ __forceinline__ void dn_chunk_prep(Frame& F, int L) {
    constexpr int TP = 136, AP = 68;
    LAS bf16* Ks = (LAS bf16*)F.lds; LAS bf16* Qs = (LAS bf16*)(F.lds + 17408); LAS bf16* Vs = (LAS bf16*)(F.lds + 34816);
    LAS float* ATs = (LAS float*)(F.lds + 52224); LAS float* GCs = (LAS float*)(F.lds + 69632); LAS float* EGs = (LAS float*)(F.lds + 69888); LAS float* BEs = (LAS float*)(F.lds + 70144);
    const bf16* QKVN = wsp<bf16>(F, WS_QKVN); const float* GB = wsp<float>(F, WS_GB);
    unsigned char* dnc = F.ws + WS_DNC;
    const int lane = F.lane, w = F.wave, lq = lane & 15, g = lane >> 4;
    v4u pre[6];
#define DNC_FETCH(uu_) do { const int n_ = (uu_) & 31, h_ = ((uu_) >> 5) & 3, b_ = (uu_) >> 7; const int row0_ = b_ * 2048 + n_ * 64; \
        _Pragma("unroll") for (int j_ = 0; j_ < 6; ++j_) { const int idx = F.tid + 512 * j_; const int m = idx >> 10, r = (idx >> 4) & 63, ch = idx & 15; \
            pre[j_] = *(const v4u*)(QKVN + (size_t)(row0_ + r) * 1536 + m * 512 + h_ * 128 + ch * 8); } } while (0)
    if (F.bid < 1024) DNC_FETCH(F.bid);
    for (int uu = F.bid; uu < 1024; uu += F.G) {
        const int n = uu & 31, h = (uu >> 5) & 3, b = uu >> 7; const int row0 = b * 2048 + n * 64;
        __syncthreads();
#pragma unroll
        for (int j_ = 0; j_ < 6; ++j_) { const int idx = F.tid + 512 * j_; const int m = idx >> 10, r = (idx >> 4) & 63, ch = idx & 15;
            LAS bf16* dst = (m == 0 ? Qs : (m == 1 ? Ks : Vs)); *(LAS v4u*)(dst + r * TP + ch * 8) = pre[j_]; }
        if (w == 0) { float x = GB[(size_t)(row0 + lane) * 8 + h]; const float be = GB[(size_t)(row0 + lane) * 8 + 4 + h];
#pragma unroll
            for (int o = 1; o < 64; o <<= 1) { const float t = __shfl_up(x, o); if (lane >= o) x += t; }
            GCs[lane] = x; EGs[lane] = expf(x); BEs[lane] = be; }
        __syncthreads();
        {
            const int type = w >> 2, it = w & 3; const LAS bf16* Xs = type ? Qs : Ks;
            bf16x8 a[4];
#pragma unroll
            for (int ks = 0; ks < 4; ++ks) a[ks] = *(const LAS bf16x8*)(Xs + (16 * it + lq) * TP + 32 * ks + 8 * g);
            bf16* aqk = (bf16*)(dnc + DNC_AQK) + (size_t)uu * 4096;
#pragma unroll
            for (int jt = 0; jt < 4; ++jt) {
                f32x4 acc = (f32x4){0.f, 0.f, 0.f, 0.f};
                if (jt <= it) {
#pragma unroll
                    for (int ks = 0; ks < 4; ++ks) { const bf16x8 bb = *(const LAS bf16x8*)(Ks + (16 * jt + lq) * TP + 32 * ks + 8 * g); acc = __builtin_amdgcn_mfma_f32_16x16x32_bf16(a[ks], bb, acc, 0, 0, 0); } }
                const int j = 16 * jt + lq; const float gcj = GCs[j];
#pragma unroll
                for (int r = 0; r < 4; ++r) { const int i = 16 * it + 4 * g + r; const float e = expf(GCs[i] - gcj);
                    if (type == 0) { ATs[j * AP + i] = (j < i) ? BEs[i] * e * acc[r] : 0.f; }
                    else { aqk[i * 64 + j] = (bf16)f2bf((j <= i) ? e * acc[r] * 0.08838834764831845f : 0.f); } }
            }
        }
        __syncthreads();
        if (uu + F.G < 1024) DNC_FETCH(uu + F.G);
        if (F.tid < 256) {
            const int c = F.tid; float r[64]; int vz = 0; asm volatile("" : "+v"(vz));
            const LAS float* ATv = ATs + vz; const LAS float* BEv = BEs + vz; const LAS float* EGv = EGs + vz;
            if (c < 128) {
#pragma unroll
                for (int i = 0; i < 64; ++i) r[i] = BEv[i] * bf2f(Vs[i * TP + c]); }
            else {
#pragma unroll
                for (int i = 0; i < 64; ++i) r[i] = BEv[i] * EGv[i] * bf2f(Ks[i * TP + (c - 128)]); }
            f32x4 cur[16];
#pragma unroll
            for (int q = 0; q < 16; ++q) cur[q] = *(const LAS f32x4*)(ATv + 4 * q);
#pragma unroll
            for (int j = 0; j < 63; ++j) {
                const float s = r[j];
#pragma unroll
                for (int q = (j + 1) / 4; q < 16; ++q) {
#pragma unroll
                    for (int e = 0; e < 4; ++e) if (4 * q + e > j) r[4 * q + e] -= cur[q][e] * s;
                    if (j < 62 && q >= (j + 2) / 4) cur[q] = *(const LAS f32x4*)(ATv + (j + 1) * AP + 4 * q);
                }
            }
            if (c < 128) {
                f32x4* U = (f32x4*)((float*)(dnc + DNC_U) + (size_t)uu * 8192) + (size_t)(c >> 4) * 256 + (c & 15) * 4;
#pragma unroll
                for (int rt = 0; rt < 4; ++rt)
#pragma unroll
                    for (int g4 = 0; g4 < 4; ++g4) U[g4 * 64 + rt] = (f32x4){r[16 * rt + 4 * g4], r[16 * rt + 4 * g4 + 1], r[16 * rt + 4 * g4 + 2], r[16 * rt + 4 * g4 + 3]}; }
            else { bf16* W = (bf16*)(dnc + DNC_W) + (size_t)uu * 8192;
#pragma unroll
                for (int i = 0; i < 64; ++i) W[i * 128 + (c - 128)] = (bf16)f2bf(-r[i]); }
        } else {
            const int tt = F.tid - 256;
            {
                const int i = tt >> 2, c0 = (tt & 3) * 32; const float sc = EGs[i] * 0.08838834764831845f; bf16* QG = (bf16*)(dnc + DNC_QG) + (size_t)uu * 8192;
#pragma unroll
                for (int j = 0; j < 4; ++j) { float f[8]; unpack8(*(const LAS v4u*)(Qs + i * TP + c0 + 8 * j), f);
#pragma unroll
                    for (int e = 0; e < 8; ++e) f[e] *= sc;
                    *(v4u*)(QG + i * 128 + c0 + 8 * j) = pack8(f); } }
            {
                const int d = tt >> 1, i0 = (tt & 1) * 32; const float gl = GCs[63]; bf16* KT = (bf16*)(dnc + DNC_KT) + (size_t)uu * 8192;
#pragma unroll
                for (int j = 0; j < 4; ++j) { float f[8];
#pragma unroll
                    for (int e = 0; e < 8; ++e) { const int i = i0 + 8 * j + e; f[e] = bf2f(Ks[i * TP + d]) * expf(gl - GCs[i]); }
                    *(v4u*)(KT + d * 64 + i0 + 8 * j) = pack8(f); } }
            if (tt == 0) ((float*)(dnc + DNC_GL))[uu] = EGs[63];
        }
    }
}
#undef DNC_FETCH

__device__ __forceinline__ void dn_scan(Frame& F, int L) {
    constexpr int TP = 136, KP = 72, BUF = 62464;
    const int lane = F.lane, w = F.wave, lq = lane & 15, g = lane >> 4;
    unsigned char* dnc = F.ws + WS_DNC; float* ORAW = wsp<float>(F, WS_ORAW);
    for (int ub = F.bid; ub < 32; ub += F.G) {
        const int b = ub >> 2, h = ub & 3;
        f32x4 S[8];
#pragma unroll
        for (int dt = 0; dt < 8; ++dt) S[dt] = (f32x4){0.f, 0.f, 0.f, 0.f};
        v4u st[7];
#define DNS_LOAD(uu) do { _Pragma("unroll") for (int p = 0; p < 7; ++p) { const int q_ = F.tid + 512 * (p & 1); \
            if (p < 2) st[p] = *(const v4u*)((const bf16*)(dnc + DNC_W) + (size_t)(uu) * 8192 + q_ * 8); \
            else if (p < 4) st[p] = *(const v4u*)((const bf16*)(dnc + DNC_QG) + (size_t)(uu) * 8192 + q_ * 8); \
            else if (p < 6) st[p] = *(const v4u*)((const bf16*)(dnc + DNC_KT) + (size_t)(uu) * 8192 + q_ * 8); \
            else st[p] = *(const v4u*)((const bf16*)(dnc + DNC_AQK) + (size_t)(uu) * 4096 + F.tid * 8); } } while (0)
#define DNS_STORE(bufp) do { _Pragma("unroll") for (int p = 0; p < 7; ++p) { const int q_ = F.tid + 512 * (p & 1); \
            if (p < 2) *(LAS v4u*)((bufp) + ((q_ >> 4) * TP + (q_ & 15) * 8) * 2) = st[p]; \
            else if (p < 4) *(LAS v4u*)((bufp) + 17408 + ((q_ >> 4) * TP + (q_ & 15) * 8) * 2) = st[p]; \
            else if (p < 6) *(LAS v4u*)((bufp) + 34816 + ((q_ >> 3) * KP + (q_ & 7) * 8) * 2) = st[p]; \
            else *(LAS v4u*)((bufp) + 53248 + ((F.tid >> 3) * KP + (F.tid & 7) * 8) * 2) = st[p]; } } while (0)
        __syncthreads();
        DNS_LOAD(ub * 32);
        f32x4 ucur[4], unxt[4];
        const float glall = ((const float*)(dnc + DNC_GL))[ub * 32 + (lane & 31)];
        { const f32x4* U0 = (const f32x4*)((const float*)(dnc + DNC_U) + (size_t)(ub * 32) * 8192) + (size_t)w * 256 + lane * 4;
#pragma unroll
          for (int rt = 0; rt < 4; ++rt) { ucur[rt] = U0[rt]; unxt[rt] = (f32x4){0.f, 0.f, 0.f, 0.f}; }
        }
        DNS_STORE(F.lds);
        __syncthreads();
        for (int n = 0; n < 32; ++n) {
            const int uu = ub * 32 + n;
            LAS unsigned char* buf = F.lds + (n & 1) * BUF;
            const LAS bf16* Wn = (const LAS bf16*)buf; const LAS bf16* QG = (const LAS bf16*)(buf + 17408); const LAS bf16* KT = (const LAS bf16*)(buf + 34816); const LAS bf16* AQ = (const LAS bf16*)(buf + 53248);
            { const int un_ = uu + (n < 31 ? 1 : 0); DNS_LOAD(un_);
                const f32x4* U1 = (const f32x4*)((const float*)(dnc + DNC_U) + (size_t)un_ * 8192) + (size_t)w * 256 + lane * 4;
#pragma unroll
                for (int rt = 0; rt < 4; ++rt) unxt[rt] = U1[rt];
            }
            f32x4 vn[4], o[4];
#pragma unroll
            for (int rt = 0; rt < 4; ++rt) { vn[rt] = ucur[rt]; o[rt] = (f32x4){0.f, 0.f, 0.f, 0.f}; }
            const float gl = __shfl(glall, n);
            bf16x8 Sb[4];
#pragma unroll
            for (int ks = 0; ks < 4; ++ks) { v4u t; t.x = pk2(S[2 * ks][0], S[2 * ks][1]); t.y = pk2(S[2 * ks][2], S[2 * ks][3]); t.z = pk2(S[2 * ks + 1][0], S[2 * ks + 1][1]); t.w = pk2(S[2 * ks + 1][2], S[2 * ks + 1][3]); Sb[ks] = __builtin_bit_cast(bf16x8, t); }
#define DNS_FRAG(base, pitch, row, k0) ({ const v2u lo_ = *(const LAS v2u*)((base) + (row) * (pitch) + (k0) + 4 * g), hi_ = *(const LAS v2u*)((base) + (row) * (pitch) + (k0) + 16 + 4 * g); v4u t_; t_.x = lo_.x; t_.y = lo_.y; t_.z = hi_.x; t_.w = hi_.y; __builtin_bit_cast(bf16x8, t_); })
#pragma unroll
            for (int hh = 0; hh < 2; ++hh) {
                bf16x8 fw[8];
#pragma unroll
                for (int rr = 0; rr < 2; ++rr)
#pragma unroll
                    for (int ks = 0; ks < 4; ++ks) fw[4 * rr + ks] = DNS_FRAG(Wn, TP, 16 * (2 * hh + rr) + lq, 32 * ks);
                __builtin_amdgcn_sched_barrier(0);
#pragma unroll
                for (int ks = 0; ks < 4; ++ks)
#pragma unroll
                    for (int rr = 0; rr < 2; ++rr) vn[2 * hh + rr] = __builtin_amdgcn_mfma_f32_16x16x32_bf16(fw[4 * rr + ks], Sb[ks], vn[2 * hh + rr], 0, 0, 0);
                __builtin_amdgcn_sched_barrier(0);
            }
#pragma unroll
            for (int hh = 0; hh < 2; ++hh) {
                bf16x8 fq[8];
#pragma unroll
                for (int rr = 0; rr < 2; ++rr)
#pragma unroll
                    for (int ks = 0; ks < 4; ++ks) fq[4 * rr + ks] = DNS_FRAG(QG, TP, 16 * (2 * hh + rr) + lq, 32 * ks);
                __builtin_amdgcn_sched_barrier(0);
#pragma unroll
                for (int ks = 0; ks < 4; ++ks)
#pragma unroll
                    for (int rr = 0; rr < 2; ++rr) o[2 * hh + rr] = __builtin_amdgcn_mfma_f32_16x16x32_bf16(fq[4 * rr + ks], Sb[ks], o[2 * hh + rr], 0, 0, 0);
                __builtin_amdgcn_sched_barrier(0);
            }
            bf16x8 vb[2];
#pragma unroll
            for (int kt = 0; kt < 2; ++kt) { v4u t; t.x = pk2(vn[2 * kt][0], vn[2 * kt][1]); t.y = pk2(vn[2 * kt][2], vn[2 * kt][3]); t.z = pk2(vn[2 * kt + 1][0], vn[2 * kt + 1][1]); t.w = pk2(vn[2 * kt + 1][2], vn[2 * kt + 1][3]); vb[kt] = __builtin_bit_cast(bf16x8, t); }
            {   bf16x8 fa[6];
                fa[0] = DNS_FRAG(AQ, KP, lq, 0); fa[1] = DNS_FRAG(AQ, KP, 16 + lq, 0); fa[2] = DNS_FRAG(AQ, KP, 32 + lq, 0); fa[3] = DNS_FRAG(AQ, KP, 32 + lq, 32); fa[4] = DNS_FRAG(AQ, KP, 48 + lq, 0); fa[5] = DNS_FRAG(AQ, KP, 48 + lq, 32);
                __builtin_amdgcn_sched_barrier(0);
                o[0] = __builtin_amdgcn_mfma_f32_16x16x32_bf16(fa[0], vb[0], o[0], 0, 0, 0); o[1] = __builtin_amdgcn_mfma_f32_16x16x32_bf16(fa[1], vb[0], o[1], 0, 0, 0);
                o[2] = __builtin_amdgcn_mfma_f32_16x16x32_bf16(fa[2], vb[0], o[2], 0, 0, 0); o[3] = __builtin_amdgcn_mfma_f32_16x16x32_bf16(fa[4], vb[0], o[3], 0, 0, 0);
                o[2] = __builtin_amdgcn_mfma_f32_16x16x32_bf16(fa[3], vb[1], o[2], 0, 0, 0); o[3] = __builtin_amdgcn_mfma_f32_16x16x32_bf16(fa[5], vb[1], o[3], 0, 0, 0);
                __builtin_amdgcn_sched_barrier(0);
            }
#pragma unroll
            for (int dt = 0; dt < 8; ++dt) S[dt] *= gl;
#pragma unroll
            for (int hh = 0; hh < 2; ++hh) {
                bf16x8 fk[8];
#pragma unroll
                for (int dd = 0; dd < 4; ++dd)
#pragma unroll
                    for (int kt = 0; kt < 2; ++kt) fk[2 * dd + kt] = DNS_FRAG(KT, KP, 16 * (4 * hh + dd) + lq, 32 * kt);
                __builtin_amdgcn_sched_barrier(0);
#pragma unroll
                for (int kt = 0; kt < 2; ++kt)
#pragma unroll
                    for (int dd = 0; dd < 4; ++dd) S[4 * hh + dd] = __builtin_amdgcn_mfma_f32_16x16x32_bf16(fk[2 * dd + kt], vb[kt], S[4 * hh + dd], 0, 0, 0);
                __builtin_amdgcn_sched_barrier(0);
            }
            float* op = ORAW + (size_t)(b * 2048 + n * 64) * 512 + h * 128 + 16 * w + lq;
#pragma unroll
            for (int rt = 0; rt < 4; ++rt)
#pragma unroll
                for (int r = 0; r < 4; ++r) op[(size_t)(16 * rt + 4 * g + r) * 512] = o[rt][r];
            DNS_STORE(F.lds + ((n + 1) & 1) * BUF);
#pragma unroll
            for (int rt = 0; rt < 4; ++rt) ucur[rt] = unxt[rt];
            __syncthreads();
        }
        float* so = F.out + O_PDNS + (((size_t)L * 8 + b) * 4 + h) * 128 * 128 + 16 * w + lq;
#pragma unroll
        for (int dt = 0; dt < 8; ++dt)
#pragma unroll
            for (int r = 0; r < 4; ++r) so[(size_t)(16 * dt + 4 * g + r) * 128] = S[dt][r];
#undef DNS_LOAD
#undef DNS_STORE
#undef DNS_FRAG
    }
}
typedef float f2v __attribute__((ext_vector_type(2)));
template <class Epi> __device__ __forceinline__ void thin_gemm(Frame& F, const bf16* A, int lda, const bf16* Bt, int K, int job, const Epi& E) {
    const int lane = F.lane, w = F.wave, lq = lane & 15, g = lane >> 4, rt = job & 7, cg = job >> 3;
    LAS float* red = (LAS float*)F.lds;
    const bf16* ap = A + (size_t)(MP + 16 * rt + lq) * lda + 8 * g;
    const bf16* bp = Bt + (size_t)(64 * cg + lq) * K + 8 * g;
    f32x4 acc[4];
#pragma unroll
    for (int ct = 0; ct < 4; ++ct) acc[ct] = (f32x4){0.f, 0.f, 0.f, 0.f};
    const int nks = K >> 5;
    bf16x8 a[4], b[4][4], an[4], bn[4][4];
#define THIN_LOAD(ks0_, a_, b_) do { _Pragma("unroll") for (int s = 0; s < 4; ++s) { const int ks = (ks0_) + 8 * s; const bool ok = ks < nks; const int kk = ok ? ks : (ks0_); \
            a_[s] = *(const bf16x8*)(ap + 32 * kk); \
            _Pragma("unroll") for (int ct = 0; ct < 4; ++ct) b_[s][ct] = *(const bf16x8*)(bp + (size_t)(16 * ct) * K + 32 * kk); \
            if (!ok) a_[s] = (bf16x8){0, 0, 0, 0, 0, 0, 0, 0}; } } while (0)
    if (w < nks) THIN_LOAD(w, a, b);
#pragma unroll 1
    for (int ks0 = w; ks0 < nks; ks0 += 32) {
        const bool hn = ks0 + 32 < nks;
        if (hn) THIN_LOAD(ks0 + 32, an, bn);
        __builtin_amdgcn_sched_barrier(0);
#pragma unroll
        for (int s = 0; s < 4; ++s)
#pragma unroll
            for (int ct = 0; ct < 4; ++ct) acc[ct] = __builtin_amdgcn_mfma_f32_16x16x32_bf16(a[s], b[s][ct], acc[ct], 0, 0, 0);
        if (hn) {
#pragma unroll
            for (int s = 0; s < 4; ++s) { a[s] = an[s];
#pragma unroll
                for (int ct = 0; ct < 4; ++ct) b[s][ct] = bn[s][ct]; } }
    }
#undef THIN_LOAD
    __syncthreads();
#pragma unroll
    for (int ct = 0; ct < 4; ++ct)
#pragma unroll
        for (int r = 0; r < 4; ++r) red[(w * 16 + 4 * g + r) * 64 + 16 * ct + lq] = acc[ct][r];
    __syncthreads();
    const int row = F.tid >> 5, c2 = 2 * (F.tid & 31);
    float v0 = 0.f, v1 = 0.f;
#pragma unroll
    for (int ww = 0; ww < 8; ++ww) { const f2v p = *(const LAS f2v*)(red + (ww * 16 + row) * 64 + c2); v0 += p[0]; v1 += p[1]; }
    E(v0, v1, MP + 16 * rt + row, 64 * cg + c2, cg, F.tid);
    __syncthreads();
}
__device__ __forceinline__ float sum32(float v) {
    return xsum16(sum16(v));
}
struct ThinResid {
    const float* xin; float* xout; bf16* xb; float* ssq; float scale;
    __device__ __forceinline__ void operator()(float v0, float v1, int row, int col, int cg, int F_tid) const {
        const size_t off = (size_t)row * 1024 + col; const f2v xi = *(const f2v*)(xin + off);
        const float x0 = xi[0] + scale * v0, x1 = xi[1] + scale * v1;
        *(f2v*)(xout + off) = (f2v){x0, x1}; *(unsigned*)(xb + off) = pk2(x0, x1);
        const float ss = sum32(x0 * x0 + x1 * x1);
        if ((F_tid & 31) == 0) ssq[(size_t)row * 16 + cg] = ss;
    }
};
struct ThinGate {
    const bf16* P; bf16* mb; int branch;
    __device__ __forceinline__ void operator()(float v0, float v1, int row, int col, int cg, int F_tid) const {
        const size_t off = (size_t)row * 1024 + col; const unsigned gw = *(const unsigned*)(P + (size_t)row * NINP + PC_GATE + branch * 1024 + col);
        float x0 = bflo(gw) * v0, x1 = bfhi(gw) * v1;
        if (branch > 0) { const unsigned mw = *(const unsigned*)(mb + off); x0 += bflo(mw); x1 += bfhi(mw); }
        *(unsigned*)(mb + off) = pk2(x0, x1);
    }
};
__device__ __forceinline__ void thin_gate4(Frame& F, const bf16* odn, const bf16* wb, const bf16* P, bf16* mb, int job) {
    const int lane = F.lane, w = F.wave, lq = lane & 15, g = lane >> 4, rt = job & 7, cg = job >> 3, br = w >> 1, kh = w & 1;
    LAS float* red = (LAS float*)F.lds;
    const bf16* ap = odn + (size_t)br * MT * 512 + (size_t)(MP + 16 * rt + lq) * 512 + 256 * kh + 8 * g;
    const bf16* bp = wb + (size_t)br * 1024 * 512 + (size_t)(64 * cg + lq) * 512 + 256 * kh + 8 * g;
    f32x4 acc[4];
#pragma unroll
    for (int ct = 0; ct < 4; ++ct) acc[ct] = (f32x4){0.f, 0.f, 0.f, 0.f};
#pragma unroll 1
    for (int s0 = 0; s0 < 8; s0 += 4) {
        bf16x8 a[4], b[4][4];
#pragma unroll
        for (int s = 0; s < 4; ++s) { a[s] = *(const bf16x8*)(ap + 32 * (s0 + s));
#pragma unroll
            for (int ct = 0; ct < 4; ++ct) b[s][ct] = *(const bf16x8*)(bp + (size_t)(16 * ct) * 512 + 32 * (s0 + s)); }
        __builtin_amdgcn_sched_barrier(0);
#pragma unroll
        for (int s = 0; s < 4; ++s)
#pragma unroll
            for (int ct = 0; ct < 4; ++ct) acc[ct] = __builtin_amdgcn_mfma_f32_16x16x32_bf16(a[s], b[s][ct], acc[ct], 0, 0, 0);
    }
    __syncthreads();
#pragma unroll
    for (int ct = 0; ct < 4; ++ct)
#pragma unroll
        for (int r = 0; r < 4; ++r) red[(w * 16 + 4 * g + r) * 64 + 16 * ct + lq] = acc[ct][r];
    __syncthreads();
    const int row = F.tid >> 5, c2 = 2 * (F.tid & 31); const size_t grow = MP + 16 * rt + row; const int col = 64 * cg + c2;
    unsigned gw[4];
#pragma unroll
    for (int bb = 0; bb < 4; ++bb) gw[bb] = *(const unsigned*)(P + grow * NINP + PC_GATE + bb * 1024 + col);
    float x0 = 0.f, x1 = 0.f;
#pragma unroll
    for (int bb = 0; bb < 4; ++bb) { const f2v p0 = *(const LAS f2v*)(red + ((2 * bb) * 16 + row) * 64 + c2), p1 = *(const LAS f2v*)(red + ((2 * bb + 1) * 16 + row) * 64 + c2);
        x0 += bflo(gw[bb]) * (p0[0] + p1[0]); x1 += bfhi(gw[bb]) * (p0[1] + p1[1]); }
    *(unsigned*)(mb + grow * 1024 + col) = pk2(x0, x1);
    __syncthreads();
}
struct ThinPlain {
    bf16* O; int ldo;
    __device__ __forceinline__ void operator()(float v0, float v1, int row, int col, int cg, int F_tid) const { *(unsigned*)(O + (size_t)row * ldo + col) = pk2(v0, v1); }
};
constexpr int N_PHASES = 3 + 12 * DEPTH;
constexpr int WF0 = 0, WF1 = 1500, WF2 = 2400, WF3 = 3500, WF4 = 7320, WF5 = 8320, WF6 = 12720, WF7 = PER_L1;
static_assert(WF7 == 14720 && WF6 < WF7, "deferred conversion slots");
#ifndef MK_ONE_LAUNCH
#define MK_ONE_LAUNCH 1
#endif
__global__ void __launch_bounds__(NWAVES * 64, 2) mk_fwd(Args args) {
    extern __shared__ __attribute__((aligned(16))) unsigned char lds_raw[];
    Frame F;
    F.lds = (LAS unsigned char*)lds_raw;
    F.tid = threadIdx.x; F.lane = F.tid & 63; F.wave = __builtin_amdgcn_readfirstlane(F.tid >> 6); F.wave0 = F.wave;
    F.G = gridDim.x; F.bid = blockIdx.x;
    F.in = (const float* const*)(args.ws + WS_TAB); F.page_table = args.page_table; F.out = args.out; F.ws = args.ws;
    volatile LAS unsigned* MISC = (volatile LAS unsigned*)(F.lds + MISC_OFF);
    for (int u = F.tid; u < (LDS_BYTES - RING_BYTES) / 4; u += NWAVES * 64) ((LAS unsigned*)(F.lds + RING_BYTES))[u] = 0u;
    __syncthreads();
    const int lo = args.ph_lo, hi = args.ph_hi;
    XcdBarrier bar; bar.bar = (unsigned*)(F.ws + WS_CTL) + CW_BAR; bar.x = 0; bar.st = nullptr; bar.w0 = F.wave0;
    if (hi - lo > 1) bar = xcd_barrier_post((unsigned*)(F.ws + WS_CTL) + CW_BAR, MISC + 8, F.wave0);
#define IN(k) (lo <= (k) && (k) < hi)
#define SEAM(k) do { if (IN(k) && IN((k) + 1)) xcd_barrier(bar); } while (0)
    using namespace pg8;
    if (IN(0)) {
        if (F.bid == 0 && F.tid == 0) { const float** tab = (const float**)(args.ws + WS_TAB);
#pragma unroll
            for (int i = 0; i < 39; ++i) tab[i] = args.in[i]; }
        launder(F); p0_weights(F, args, F.G == 256); launder(F); p0_rows(F, args); }
    SEAM(0);
    for (int L = 0; L < DEPTH; ++L) {
        const int pb = 3 + 12 * L;
        const bool last = (L == DEPTH - 1);
        if (IN(pb + 0)) { launder(F);
            Gemm g{wsp<bf16>(F, WS_XB), wl(F, L, WL_GU1), MT, 5632, 1024, 1024}; StaticOrder S; S.init(MT, 5632, F.G, F.bid);
            EpiSwiglu E{wsp<bf16>(F, WS_ACT), DFF, ssqbuf(F, 3 * L)};
            gemm_phase<EpiSwiglu, StaticOrder, true, true>(F.lds, g, S, E, F.tid);
            if (L == 0) {
                launder(F);
                const int short0 = (65 * 22) % F.G, vb = F.bid - short0;
                if (short0 > 0 && F.G - short0 >= 64) { if (vb >= 0 && vb < 64) { Gemm g2{wsp<bf16>(F, WS_MEMB), wsp<bf16>(F, WS_WMEMKV), 2048, 2048, 1024, 1024}; StaticOrder S2; S2.init(2048, 2048, 64, vb);
                        EpiMemKV E2{F.out + O_PMK, (size_t)(O_PMV - O_PMK)}; gemm_phase<EpiMemKV, StaticOrder, true, true>(F.lds, g2, S2, E2, F.tid); } }
                else { Gemm g2{wsp<bf16>(F, WS_MEMB), wsp<bf16>(F, WS_WMEMKV), 2048, 2048, 1024, 1024}; StaticOrder S2; S2.init(2048, 2048, F.G, F.bid);
                        EpiMemKV E2{F.out + O_PMK, (size_t)(O_PMV - O_PMK)}; gemm_phase<EpiMemKV, StaticOrder, true, true>(F.lds, g2, S2, E2, F.tid); }
            }
            if (L == 0 && F.G == 256 && F.bid >= 214) { __syncthreads(); launder(F); w1_fill(F, F.bid - 214, 42, WF0, WF1); }
        }
        SEAM(pb + 0);
        if (IN(pb + 1)) { launder(F);
            Gemm g{wsp<bf16>(F, WS_ACT), wl(F, L, WL_D1), MP, 1024, DFF, DFF}; StaticOrder S; S.init(MP, 1024, F.G, F.bid);
            EpiResid E{wsp<float>(F, WS_X), wsp<float>(F, WS_X), wsp<bf16>(F, WS_XB), ssqbuf(F, 3 * L + 1), 0.5f, MT};
            gemm_phase<EpiResid, StaticOrder, true, true>(F.lds, g, S, E, F.tid);
            launder(F);
            if (F.bid < 128) { ThinResid T{wsp<float>(F, WS_X), wsp<float>(F, WS_X), wsp<bf16>(F, WS_XB), ssqbuf(F, 3 * L + 1), 0.5f}; thin_gemm(F, wsp<bf16>(F, WS_ACT), DFF, wl(F, L, WL_D1), DFF, F.bid, T); }
            if (L == 0) { launder(F); if (F.G > 128) { if (F.bid >= 128) p2_memkv_post(F, F.bid - 128, F.G - 128); } else p2_memkv_post(F, F.bid, F.G); }
            if (L == 0 && F.G == 256 && F.bid >= 128) { __syncthreads(); launder(F); w1_fill(F, F.bid - 128, 128, WF1, WF2); }
        }
        SEAM(pb + 1);
        if (IN(pb + 2)) { launder(F);
            Gemm g{wsp<bf16>(F, WS_XB), wl(F, L, WL_IN), MT, NINP, 1024, 1024}; StaticOrder S; S.init(MT, NINP, F.G, F.bid);
            EpiWin E{wsp<bf16>(F, WS_P), wsp<float>(F, WS_SIDE), ssqbuf(F, 3 * L + 1)};
            gemm_phase<EpiWin, StaticOrder, true, true>(F.lds, g, S, E, F.tid);
            if (L == 0 && F.G == 256 && F.bid >= 227) { __syncthreads(); launder(F); w1_fill(F, F.bid - 227, 29, WF2, WF3); }
        }
        SEAM(pb + 2);
        if (IN(pb + 3)) { launder(F); prep_rows(F, L); }
        SEAM(pb + 3);
        if (IN(pb + 4)) { launder(F);
            {
                Gemm g{wsp<bf16>(F, WS_CQB), wl(F, L, WL_QB), MP, 1024, launder_int(256), 256}; MultiOrder S; S.init(MP, 1024, F.G, F.bid); S.nb = 2; S.pmstride = 65; S.pnstride = 4;
                EpiPlainM E{wsp<bf16>(F, WS_QRAW), (size_t)MT * 1024};
                gemm_phase<EpiPlainM, MultiOrder, true, true>(F.lds, g, S, E, F.tid);
            }
#pragma unroll 1
            for (int i = 0; i < 2; ++i) { launder(F);
                const int job = F.G >= 256 ? (i == 0 ? F.bid : F.bid - 128) : F.bid;
                if (job >= 0 && job < 128) { ThinPlain T{wsp<bf16>(F, WS_QRAW + (size_t)i * (WS_KVRAW - WS_QRAW)), 1024}; thin_gemm(F, wsp<bf16>(F, WS_CQB + (size_t)i * (WS_CKVB - WS_CQB)), 256, wl(F, L, WL_QB + (size_t)i * (WL_KVB - WL_QB)), 256, job, T); }
            }
            launder(F); dn_chunk_prep(F, L);
        }
        SEAM(pb + 4);
        if (IN(pb + 5)) { launder(F); mla_post(F, L); launder(F); wuk_swizzle(F, L); }
        SEAM(pb + 5);
        if (IN(pb + 6)) { launder(F); dn_scan(F, L); __syncthreads(); launder(F); dn_seq(F, L); __syncthreads(); launder(F); mla_prompt_attn(F); __syncthreads(); launder(F); mem_attn(F, L); __syncthreads(); launder(F); mla_sample_attn(F, L); }
        SEAM(pb + 6);
        if (IN(pb + 7)) { launder(F); mla_sample_combine(F, L); launder(F); dn_post(F, L); }
        SEAM(pb + 7);
        if (IN(pb + 8)) { launder(F);
            if (F.bid < 128) thin_gate4(F, wsp<bf16>(F, WS_ODN), wl(F, L, WL_DNO), wsp<bf16>(F, WS_P), wsp<bf16>(F, WS_MB), F.bid);
            __syncthreads(); launder(F);
            {
                Gemm g{wsp<bf16>(F, WS_ODN), wl(F, L, WL_DNO), MP, 1024, 512, 512}; MultiOrder S; S.init(MP, 1024, F.G, F.bid); S.nb = 4; S.pmstride = 65; S.pnstride = 4;
                EpiGateM E{wsp<bf16>(F, WS_P), wsp<bf16>(F, WS_MB)};
                gemm_phase<EpiGateM, MultiOrder, true, true>(F.lds, g, S, E, F.tid);
            }
            if (L == 0 && F.G == 256 && F.bid >= 128) { __syncthreads(); launder(F); w1_fill(F, F.bid - 128, 128, WF3, WF4); }
        }
        SEAM(pb + 8);
        if (IN(pb + 9)) { launder(F);
            Gemm g{wsp<bf16>(F, WS_MB), wl(F, L, WL_WO), MP, 1024, 1024, 1024}; StaticOrder S; S.init(MP, 1024, F.G, F.bid);
            EpiResid E{wsp<float>(F, WS_X), wsp<float>(F, WS_X), wsp<bf16>(F, WS_XB), ssqbuf(F, 3 * L + 2), 1.0f, MT};
            gemm_phase<EpiResid, StaticOrder, true, true>(F.lds, g, S, E, F.tid);
            launder(F);
            if (F.bid < 128) { ThinResid T{wsp<float>(F, WS_X), wsp<float>(F, WS_X), wsp<bf16>(F, WS_XB), ssqbuf(F, 3 * L + 2), 1.0f}; thin_gemm(F, wsp<bf16>(F, WS_MB), 1024, wl(F, L, WL_WO), 1024, F.bid, T); }
            if (L == 0 && F.G == 256 && F.bid >= 128) { __syncthreads(); launder(F); w1_fill(F, F.bid - 128, 128, WF4, WF5); }
        }
        SEAM(pb + 9);
        if (IN(pb + 10)) { launder(F);
            Gemm g{wsp<bf16>(F, WS_XB), wl(F, L, WL_GU2), MT, 5632, 1024, 1024}; StaticOrder S; S.init(MT, 5632, F.G, F.bid);
            EpiSwiglu E{wsp<bf16>(F, WS_ACT), DFF, ssqbuf(F, 3 * L + 2)};
            gemm_phase<EpiSwiglu, StaticOrder, true, true>(F.lds, g, S, E, F.tid);
            if (L == 0 && F.G == 256 && F.bid >= 150) { __syncthreads(); launder(F); w1_fill(F, F.bid - 150, 106, WF5, WF6); }
        }
        SEAM(pb + 10);
        if (IN(pb + 11)) { launder(F);
            Gemm g{wsp<bf16>(F, WS_ACT), wl(F, L, WL_D2), MP, 1024, DFF, DFF}; StaticOrder S; S.init(MP, 1024, F.G, F.bid);
            EpiResid E{wsp<float>(F, WS_X), last ? F.out : wsp<float>(F, WS_X), wsp<bf16>(F, WS_XB), ssqbuf(F, 3 * L + 3), 0.5f, last ? MV : MT};
            gemm_phase<EpiResid, StaticOrder, true, true>(F.lds, g, S, E, F.tid);
            launder(F);
            if (F.bid < 128) { ThinResid T{wsp<float>(F, WS_X), last ? F.out : wsp<float>(F, WS_X), wsp<bf16>(F, WS_XB), ssqbuf(F, 3 * L + 3), 0.5f}; thin_gemm(F, wsp<bf16>(F, WS_ACT), DFF, wl(F, L, WL_D2), DFF, F.bid, T); }
            if (L == 0 && F.G == 256 && F.bid >= 128) { __syncthreads(); launder(F); w1_fill(F, F.bid - 128, 128, WF6, WF7); }
        }
        SEAM(pb + 11);
    }
#undef IN
#undef SEAM
}

extern "C" void kernel_launch(void* const* d_in, const int* in_sizes, int n_in, void* d_out, int out_size, void* d_ws, size_t ws_size, hipStream_t stream) {
    static int grid = 0;
    if (grid == 0) {
        if (n_in != 39 || out_size != (int)O_END || ws_size < WS_END) { fprintf(stderr, "kernel_launch: unexpected sizes n_in %d out %d ws %zu (need %zu)\n", n_in, out_size, ws_size, (size_t)WS_END); grid = -1; return; }
        int dev = 0, cus = 0;
        if (hipGetDevice(&dev) != hipSuccess || hipDeviceGetAttribute(&cus, hipDeviceAttributeMultiprocessorCount, dev) != hipSuccess) { grid = -1; return; }
        if (hipFuncSetAttribute((const void*)mk_fwd, hipFuncAttributeMaxDynamicSharedMemorySize, LDS_BYTES) != hipSuccess) { fprintf(stderr, "kernel_launch: hipFuncSetAttribute failed\n"); grid = -1; return; }
        int per_cu = 0;
        if (hipOccupancyMaxActiveBlocksPerMultiprocessor(&per_cu, (const void*)mk_fwd, NWAVES * 64, LDS_BYTES) != hipSuccess || per_cu < 1) fprintf(stderr, "kernel_launch: occupancy query reports %d\n", per_cu);
        (void)hipGetLastError();
        grid = cus;
    }
    if (grid < 0) return;
    (void)hipMemsetAsync((char*)d_ws + WS_CTL, 0, CTL_ZERO_BYTES, stream);
    Args a{};
    for (int i = 0; i < 39; ++i) a.in[i] = (const float*)d_in[i];
    a.page_table = (const int*)d_in[9]; a.out = (float*)d_out; a.ws = (unsigned char*)d_ws;
#if MK_ONE_LAUNCH
    a.ph_lo = 0; a.ph_hi = N_PHASES;
    hipLaunchKernelGGL(mk_fwd, dim3(grid), dim3(NWAVES * 64), LDS_BYTES, stream, a);
#else
    for (int p = 0; p < N_PHASES; ++p) { a.ph_lo = p; a.ph_hi = p + 1; hipLaunchKernelGGL(mk_fwd, dim3(grid), dim3(NWAVES * 64), LDS_BYTES, stream, a); }
#endif
}
```

```cpp
#include <hip/hip_runtime.h>
#include <cstdio>
#include <cstdint>

#define GAS __attribute__((address_space(1)))
#define LAS __attribute__((address_space(3)))
typedef unsigned short bf16;
typedef unsigned v4u __attribute__((ext_vector_type(4)));
typedef unsigned v2u __attribute__((ext_vector_type(2)));
typedef float f32x4 __attribute__((ext_vector_type(4)));
typedef short bf16x8 __attribute__((ext_vector_type(8)));

constexpr int D = 1024, NB = 8, SEQ = 2048, DEPTH = 2, DBATCH = 32, DSEQ = 4, PAGE = 128, NPAGES = 128, NPHYS = 5120;
constexpr int MP = NB * SEQ;
constexpr int MS = DBATCH * DSEQ;
constexpr int MV = MP + MS;
constexpr int MT = 16640;
constexpr int DFF = 2816, NIN = 8744, NINP = 8960;
constexpr int NMEM = 256, NSEQ = NB + DBATCH;
constexpr float EPS = 1e-6f;
constexpr float LOG2E = 1.4426950408889634f;
constexpr int PC_QKV = 0, PC_Z = 1536, PC_SCB = 2048, PC_SCC = 2560, PC_SCX = 3072, PC_MQ = 3584, PC_MKV = 3840, PC_MEMQ = 4096, PC_GATE = 4608, PC_KR = 8704, PC_AB = 8736;

constexpr size_t O_YP = 0;
constexpr size_t O_YS = O_YP + (size_t)MP * D;
constexpr size_t O_PDNS = O_YS + (size_t)MS * D;
constexpr size_t O_PDNC = O_PDNS + (size_t)DEPTH * NB * 4 * 128 * 128;
constexpr size_t O_PSCC = O_PDNC + (size_t)DEPTH * NB * 3 * 1536;
constexpr size_t O_PCKV = O_PSCC + (size_t)DEPTH * NB * 2 * 512;
constexpr size_t O_PKR = O_PCKV + (size_t)DEPTH * NB * SEQ * 256;
constexpr size_t O_PMK = O_PKR + (size_t)DEPTH * NB * SEQ * 32;
constexpr size_t O_PMV = O_PMK + (size_t)DEPTH * NB * NMEM * 512;
constexpr size_t O_SDNS = O_PMV + (size_t)DEPTH * NB * NMEM * 512;
constexpr size_t O_SDNC = O_SDNS + (size_t)DEPTH * DBATCH * 4 * 128 * 128;
constexpr size_t O_SSCC = O_SDNC + (size_t)DEPTH * DBATCH * 3 * 1536;
constexpr size_t O_SCKV = O_SSCC + (size_t)DEPTH * DBATCH * 2 * 512;
constexpr size_t O_SKR = O_SCKV + (size_t)DEPTH * DBATCH * DSEQ * 256;
constexpr size_t O_END = O_SKR + (size_t)DEPTH * DBATCH * DSEQ * 32;
static_assert(O_END == 36306944, "output size");

constexpr size_t al256(size_t x) { return (x + 255) & ~(size_t)255; }
constexpr size_t WS_CTL = 0, CTL_ZERO_BYTES = 1u << 20;
constexpr int CW_BAR = 4096;

constexpr size_t WL_GU1 = 0;
constexpr size_t WL_D1 = WL_GU1 + (size_t)5632 * 1024 * 2;
constexpr size_t WL_IN = WL_D1 + (size_t)1024 * 2816 * 2;
constexpr size_t WL_DNO = WL_IN + (size_t)NINP * 1024 * 2;
constexpr size_t WL_SCO = WL_DNO + (size_t)1024 * 512 * 2;
constexpr size_t WL_MLAO = WL_SCO + (size_t)1024 * 512 * 2;
constexpr size_t WL_MEMO = WL_MLAO + (size_t)1024 * 512 * 2;
constexpr size_t WL_QB = WL_MEMO + (size_t)1024 * 512 * 2;
constexpr size_t WL_KVB = WL_QB + (size_t)1024 * 256 * 2;
constexpr size_t WL_WO = WL_KVB + (size_t)1024 * 256 * 2;
constexpr size_t WL_GU2 = WL_WO + (size_t)1024 * 1024 * 2;
constexpr size_t WL_D2 = WL_GU2 + (size_t)5632 * 1024 * 2;
constexpr size_t WL_SIZE = al256(WL_D2 + (size_t)1024 * 2816 * 2);
constexpr size_t WS_W = CTL_ZERO_BYTES;
constexpr size_t WS_WMEMKV = WS_W + 2 * WL_SIZE;
constexpr size_t WS_X = al256(WS_WMEMKV + (size_t)2048 * 1024 * 2);
constexpr size_t WS_XB = WS_X + (size_t)MT * D * 4;
constexpr size_t WS_ACT = WS_XB + (size_t)MT * D * 2;
constexpr size_t WS_P = WS_ACT + (size_t)MT * DFF * 2;
constexpr size_t WS_SIDE = WS_P + (size_t)MT * NINP * 2;
constexpr size_t WS_QKVN = WS_SIDE + (size_t)MT * 64 * 4;
constexpr size_t WS_GB = WS_QKVN + (size_t)MT * 1536 * 2;
constexpr size_t WS_ODN = WS_GB + (size_t)MT * 8 * 4;
constexpr size_t WS_OSC = WS_ODN + (size_t)MT * 512 * 2;
constexpr size_t WS_OMLA = WS_OSC + (size_t)MT * 512 * 2;
constexpr size_t WS_OMEM = WS_OMLA + (size_t)MT * 512 * 2;
constexpr size_t WS_CQB = WS_OMEM + (size_t)MT * 512 * 2;
constexpr size_t WS_CKVB = WS_CQB + (size_t)MT * 256 * 2;
constexpr size_t WS_KRB = WS_CKVB + (size_t)MT * 256 * 2;
constexpr size_t WS_QMB = WS_KRB + (size_t)MT * 32 * 4;
constexpr size_t WS_QRAW = WS_QMB + (size_t)MT * 512 * 2;
constexpr size_t WS_KVRAW = WS_QRAW + (size_t)MT * 1024 * 2;
constexpr size_t WS_QF = WS_KVRAW + (size_t)MT * 1024 * 2;
constexpr size_t WS_QSG = WS_QF + (size_t)MT * 768 * 2;
constexpr size_t WS_KF = WS_QSG + (size_t)MS * 768 * 2;
constexpr size_t WS_KFS = WS_KF + (size_t)MP * 768 * 2;
constexpr size_t WS_VT = WS_KFS + (size_t)MS * 768 * 2;
constexpr size_t WS_ORAW = WS_VT + (size_t)64 * 64 * 2048 * 2;
constexpr size_t WS_MERGED = WS_ORAW + (size_t)MT * 512 * 4;
constexpr size_t WS_WUKS = WS_MERGED;
constexpr size_t WS_MB = WS_MERGED + (size_t)MT * D * 4;
constexpr size_t WS_MEMB = WS_MB + (size_t)MT * D * 2;
constexpr size_t WS_MK = WS_MEMB + (size_t)2048 * 1024 * 2;
constexpr size_t WS_MVT = WS_MK + (size_t)2 * NSEQ * 4 * 256 * 128 * 2;
constexpr size_t WS_PART = WS_MVT + (size_t)2 * NSEQ * 4 * 256 * 128 * 2;
constexpr size_t WS_ML = WS_PART + (size_t)32 * 32 * 32 * 256 * 4;
constexpr size_t WS_ROPE = WS_ML + (size_t)32 * 32 * 32 * 2 * 4;
constexpr size_t WS_TAB = al256(WS_ROPE + (size_t)2052 * 32 * 4);
constexpr size_t WS_SSQ = al256(WS_TAB + 64 * 8);
constexpr size_t WS_DNC = al256(WS_SSQ + 7 * (size_t)MT * 16 * 4);
constexpr size_t WS_DNC_BYTES = (size_t)100 << 20;
constexpr size_t WS_END = al256(WS_DNC + WS_DNC_BYTES);

constexpr int LDS_BYTES = 147456;
constexpr int RING_BYTES = 131072;
constexpr int MISC_OFF = RING_BYTES + 320;
constexpr int NWAVES = 8;

#define RLX_AGENT __ATOMIC_RELAXED, __HIP_MEMORY_SCOPE_AGENT
__device__ __forceinline__ unsigned f2bf(float f) { unsigned u = __builtin_bit_cast(unsigned, f); return (u + 0x7fffu + ((u >> 16) & 1u)) >> 16; }
__device__ __forceinline__ unsigned pk2(float lo, float hi) { unsigned r; asm("v_cvt_pk_bf16_f32 %0, %1, %2" : "=v"(r) : "v"(lo), "v"(hi)); return r; }
__device__ __forceinline__ float bflo(unsigned w) { return __builtin_bit_cast(float, w << 16); }
__device__ __forceinline__ float bfhi(unsigned w) { return __builtin_bit_cast(float, w & 0xffff0000u); }
__device__ __forceinline__ float bf2f(bf16 b) { return __builtin_bit_cast(float, ((unsigned)b) << 16); }
__device__ __forceinline__ float fexp2(float x) { return __builtin_amdgcn_exp2f(x); }
__device__ __forceinline__ float frcp(float x) { return __builtin_amdgcn_rcpf(x); }
__device__ __forceinline__ float silu_f(float x) { return x * frcp(1.0f + fexp2(-x * LOG2E)); }
__device__ __forceinline__ float sigmoid_f(float x) { return frcp(1.0f + fexp2(-x * LOG2E)); }
__device__ __forceinline__ void unpack8(v4u w, float* f) { f[0] = bflo(w.x); f[1] = bfhi(w.x); f[2] = bflo(w.y); f[3] = bfhi(w.y); f[4] = bflo(w.z); f[5] = bfhi(w.z); f[6] = bflo(w.w); f[7] = bfhi(w.w); }
__device__ __forceinline__ v4u pack8(const float* f) { v4u w; w.x = pk2(f[0], f[1]); w.y = pk2(f[2], f[3]); w.z = pk2(f[4], f[5]); w.w = pk2(f[6], f[7]); return w; }
template <int CTRL> __device__ __forceinline__ float dppf(float v) { return __builtin_bit_cast(float, __builtin_amdgcn_update_dpp(0, __builtin_bit_cast(int, v), CTRL, 0xf, 0xf, true)); }
__device__ __forceinline__ float rsq_f(float x) { return __builtin_amdgcn_rsqf(x); }
__device__ __forceinline__ float row4_sum(float v) { v += dppf<0xB1>(v); v += dppf<0x4E>(v); return v; }
__device__ __forceinline__ float row8_sum(float v) { v = row4_sum(v); v += dppf<0x141>(v); return v; }
__device__ __forceinline__ float sum16(float v) { v = row8_sum(v); v += dppf<0x140>(v); return v; }
__device__ __forceinline__ float max16(float v) { v = fmaxf(v, dppf<0xB1>(v)); v = fmaxf(v, dppf<0x4E>(v)); v = fmaxf(v, dppf<0x141>(v)); v = fmaxf(v, dppf<0x140>(v)); return v; }
__device__ __forceinline__ float xsum16(float v) { return v + __shfl_xor(v, 16); }
__device__ __forceinline__ float xsum32(float v) { return v + __shfl_xor(v, 32); }
__device__ __forceinline__ float xmax16(float v) { return fmaxf(v, __shfl_xor(v, 16)); }
__device__ __forceinline__ float xmax32(float v) { return fmaxf(v, __shfl_xor(v, 32)); }
__device__ __forceinline__ float xrow_sum(float v) { return xsum32(xsum16(v)); }
__device__ __forceinline__ float xrow_max(float v) { return xmax32(xmax16(v)); }
__device__ __forceinline__ float wave_sum(float v) { return xrow_sum(sum16(v)); }
namespace pg8 {
#define PG8_LAS __attribute__((address_space(3)))
typedef unsigned short bf16_t;
typedef short bf16x8 __attribute__((ext_vector_type(8)));
typedef float f32x4 __attribute__((ext_vector_type(4)));
typedef unsigned u32x4 __attribute__((ext_vector_type(4)));
constexpr int BM = 256, BK = 64, HALF = 128, HTB = HALF * BK * 2  , STAGE_BYTES = 8 * HTB, NXCD = 8, WGM = 8;

__host__ __device__ __forceinline__ int lds_byte(int r, int c) { const int st = (r >> 4) * 2 + (c >> 5), rr = r & 15, cc = c & 31, ob = rr * 64 + cc * 2; return st * 1024 + (ob ^ (((ob >> 9) & 1) << 5)); }
__host__ __device__ __forceinline__ void stage_rc(int b, int& R, int& C) { const int st = b / 1024, sb = b % 1024, swz = sb ^ (((sb >> 9) & 1) << 5); R = (st >> 1) * 16 + swz / 64; C = (st & 1) * 32 + (swz % 64) / 2; }
__host__ __device__ __forceinline__ int perm32(int rho) { const int n = rho >> 4, i = rho & 15; return 8 * (i >> 2) + 4 * n + (i & 3); }

struct Unit { int pm, pn; };
struct Gemm { const bf16_t* A; const bf16_t* Bt; int M, N, K, lda; };

struct StaticOrder {
    int nM, nN, nwg, G, c;
    __host__ __device__ void init(int M, int N, int G_, int c_) { nM = M / BM; nN = N / BM; nwg = nM * nN; G = G_; c = c_; }
    __host__ __device__ bool next(int i, Unit& u) const {
        const long L = (long)i * G + c; if (L >= nwg) return false;
        int wgid = (int)L; { const int q = nwg / NXCD, r = nwg % NXCD, xcd = wgid % NXCD, off = wgid / NXCD; wgid = (xcd < r ? xcd * (q + 1) : r * (q + 1) + (xcd - r) * q) + off; }
        const int nig = WGM * nN, gid = wgid / nig, fm = gid * WGM, gsz = (nM - fm) < WGM ? (nM - fm) : WGM;
        u.pm = fm + ((wgid % nig) % gsz); u.pn = (wgid % nig) / gsz; return true;
    }
    __device__ __forceinline__ void a_ready(const Unit&) const {}
    __device__ __forceinline__ void done(const Unit&) const {}
};

__device__ __forceinline__ unsigned cvt_pk_bf16(float lo, float hi) { unsigned r; asm volatile("v_cvt_pk_bf16_f32 %0, %1, %2" : "=v"(r) : "v"(lo), "v"(hi)); return r; }
typedef float f32x2 __attribute__((ext_vector_type(2)));
typedef unsigned u32x2 __attribute__((ext_vector_type(2)));
__device__ __forceinline__ float ep_rstd(const float* ssq, int row) {
    const f32x4 a = *(const f32x4*)(ssq + (size_t)row * 16), b = *(const f32x4*)(ssq + (size_t)row * 16 + 4), c = *(const f32x4*)(ssq + (size_t)row * 16 + 8), d = *(const f32x4*)(ssq + (size_t)row * 16 + 12);
    const float s = (((a[0] + a[1]) + (a[2] + a[3])) + ((b[0] + b[1]) + (b[2] + b[3]))) + (((c[0] + c[1]) + (c[2] + c[3])) + ((d[0] + d[1]) + (d[2] + d[3])));
    return rsq_f(s * (1.0f / 1024.0f) + 1e-6f); }
__device__ __forceinline__ void ep_rstd8(const float* ssq, int row0, int fq, float (&rsv)[2][4]) {
    f32x4 q[2][4];
#pragma unroll
    for (int ai = 0; ai < 2; ++ai)
#pragma unroll
        for (int m = 0; m < 4; ++m) q[ai][m] = *(const f32x4*)(ssq + (size_t)(row0 + ai * 128 + m * 16) * 16 + 4 * fq);
#pragma unroll
    for (int ai = 0; ai < 2; ++ai)
#pragma unroll
        for (int m = 0; m < 4; ++m) { float s = (q[ai][m][0] + q[ai][m][1]) + (q[ai][m][2] + q[ai][m][3]); s = xrow_sum(s); rsv[ai][m] = rsq_f(s * (1.0f / 1024.0f) + 1e-6f); }
}
__device__ __forceinline__ float ep_silu(float x) { return x * __builtin_amdgcn_rcpf(1.0f + __builtin_amdgcn_exp2f(-x * 1.4426950408889634f)); }
__device__ __forceinline__ float ep_sigm(float x) { return __builtin_amdgcn_rcpf(1.0f + __builtin_amdgcn_exp2f(-x * 1.4426950408889634f)); }
struct EpiSwiglu {
    static constexpr bool PERM = true, AFTER_DRAIN = false, RSTD = true;
    bf16_t* O; int ldo; const float* ssq;
    __device__ __forceinline__ void operator()(const f32x4 (&acc)[2][2][4][2], const Unit& u, int wr, int wc, int fr, int fq, const float (&rsv)[2][4]) const {
        const int row0 = u.pm * BM + wr * 64 + fr, col0 = u.pn * 128 + wc * 32 + 8 * fq;
#pragma unroll
        for (int ai = 0; ai < 2; ++ai)
#pragma unroll
            for (int m = 0; m < 4; ++m) { const int row = row0 + ai * HALF + m * 16; const float rs = rsv[ai][m];
                const f32x4 g0 = acc[ai][0][m][0] * rs, g1 = acc[ai][0][m][1] * rs, u0 = acc[ai][1][m][0] * rs, u1 = acc[ai][1][m][1] * rs;
                u32x4 w; w.x = cvt_pk_bf16(ep_silu(g0[0]) * u0[0], ep_silu(g0[1]) * u0[1]); w.y = cvt_pk_bf16(ep_silu(g0[2]) * u0[2], ep_silu(g0[3]) * u0[3]);
                w.z = cvt_pk_bf16(ep_silu(g1[0]) * u1[0], ep_silu(g1[1]) * u1[1]); w.w = cvt_pk_bf16(ep_silu(g1[2]) * u1[2], ep_silu(g1[3]) * u1[3]);
                *(u32x4*)(O + (size_t)row * ldo + col0) = w; }
    }
};
struct EpiResid {
    static constexpr bool PERM = false, AFTER_DRAIN = false, RSTD = false;
    const float* xin; float* xout; bf16_t* xb; float* ssq; float scale; int row_limit;
    __device__ __forceinline__ void operator()(const f32x4 (&acc)[2][2][4][2], const Unit& u, int wr, int wc, int fr, int fq) const {
        const int row0 = u.pm * BM + wr * 64 + fr, col0 = u.pn * BM + wc * 32 + 4 * fq;
#pragma unroll
        for (int ai = 0; ai < 2; ++ai) {
            f32x4 xv[4][2][2];
#pragma unroll
            for (int m = 0; m < 4; ++m)
#pragma unroll
                for (int bj = 0; bj < 2; ++bj)
#pragma unroll
                    for (int n = 0; n < 2; ++n) xv[m][bj][n] = *(const f32x4*)(xin + (size_t)(row0 + ai * HALF + m * 16) * 1024 + col0 + bj * HALF + n * 16);
            __builtin_amdgcn_sched_barrier(0);
#pragma unroll
            for (int m = 0; m < 4; ++m) { const int row = row0 + ai * HALF + m * 16; const bool ok = row < row_limit; float ss = 0.f;
#pragma unroll
                for (int bj = 0; bj < 2; ++bj)
#pragma unroll
                    for (int n = 0; n < 2; ++n) { const size_t off = (size_t)row * 1024 + col0 + bj * HALF + n * 16;
                        const f32x4 x = xv[m][bj][n] + acc[ai][bj][m][n] * scale;
                        if (ok) { *(f32x4*)(xout + off) = x; u32x2 w; w.x = cvt_pk_bf16(x[0], x[1]); w.y = cvt_pk_bf16(x[2], x[3]); *(u32x2*)(xb + off) = w; }
                        ss += (x[0] * x[0] + x[1] * x[1]) + (x[2] * x[2] + x[3] * x[3]); }
                ss = xrow_sum(ss);
                if (ok && fq == 0) ssq[(size_t)row * 16 + u.pn * 4 + wc] = ss; }
        }
    }
};
struct EpiWin {
    static constexpr bool PERM = true, AFTER_DRAIN = false, RSTD = true;
    bf16_t* P; float* side; const float* ssq;
    __device__ __forceinline__ void operator()(const f32x4 (&acc)[2][2][4][2], const Unit& u, int wr, int wc, int fr, int fq, const float (&rsv)[2][4]) const {
        const int row0 = u.pm * BM + wr * 64 + fr, colt = wc * 32 + 8 * fq; const bool sg = (u.pn >= 18 && u.pn < 34);
#pragma unroll
        for (int ai = 0; ai < 2; ++ai)
#pragma unroll
            for (int m = 0; m < 4; ++m) { const int row = row0 + ai * HALF + m * 16; const float rs = rsv[ai][m];
#pragma unroll
                for (int bj = 0; bj < 2; ++bj) { f32x4 v0 = acc[ai][bj][m][0] * rs, v1 = acc[ai][bj][m][1] * rs; const int cl = colt + bj * HALF;
                    if (u.pn == 34 && cl < 40) { *(f32x4*)(side + (size_t)row * 64 + cl) = v0; *(f32x4*)(side + (size_t)row * 64 + cl + 4) = v1; }
                    if (sg) {
#pragma unroll
                        for (int j = 0; j < 4; ++j) { v0[j] = ep_sigm(v0[j]); v1[j] = ep_sigm(v1[j]); } }
                    u32x4 w; w.x = cvt_pk_bf16(v0[0], v0[1]); w.y = cvt_pk_bf16(v0[2], v0[3]); w.z = cvt_pk_bf16(v1[0], v1[1]); w.w = cvt_pk_bf16(v1[2], v1[3]);
                    *(u32x4*)(P + (size_t)row * 8960 + u.pn * BM + cl) = w; } }
    }
};
struct EpiPlain {
    static constexpr bool PERM = true, AFTER_DRAIN = false, RSTD = false;
    bf16_t* O; int ldo;
    __device__ __forceinline__ void operator()(const f32x4 (&acc)[2][2][4][2], const Unit& u, int wr, int wc, int fr, int fq) const {
        const int row0 = u.pm * BM + wr * 64 + fr, col0 = u.pn * BM + wc * 32 + 8 * fq;
#pragma unroll
        for (int ai = 0; ai < 2; ++ai)
#pragma unroll
            for (int m = 0; m < 4; ++m) { const int row = row0 + ai * HALF + m * 16;
#pragma unroll
                for (int bj = 0; bj < 2; ++bj) { const f32x4 v0 = acc[ai][bj][m][0], v1 = acc[ai][bj][m][1];
                    u32x4 w; w.x = cvt_pk_bf16(v0[0], v0[1]); w.y = cvt_pk_bf16(v0[2], v0[3]); w.z = cvt_pk_bf16(v1[0], v1[1]); w.w = cvt_pk_bf16(v1[2], v1[3]);
                    *(u32x4*)(O + (size_t)row * ldo + col0 + bj * HALF) = w; } }
    }
};
struct EpiGate {
    static constexpr bool PERM = true, AFTER_DRAIN = false, RSTD = false;
    const bf16_t* P; bf16_t* mb; int branch;
    __device__ __forceinline__ void operator()(const f32x4 (&acc)[2][2][4][2], const Unit& u, int wr, int wc, int fr, int fq) const {
        const int row0 = u.pm * BM + wr * 64 + fr, col0 = u.pn * BM + wc * 32 + 8 * fq;
#pragma unroll
        for (int ai = 0; ai < 2; ++ai)
#pragma unroll
            for (int m = 0; m < 4; ++m) { const int row = row0 + ai * HALF + m * 16;
#pragma unroll
                for (int bj = 0; bj < 2; ++bj) { const int c = col0 + bj * HALF; const size_t off = (size_t)row * 1024 + c;
                    const u32x4 gw = *(const u32x4*)(P + (size_t)row * 8960 + 4608 + branch * 1024 + c);
                    float x[8];
#pragma unroll
                    for (int j = 0; j < 4; ++j) { x[2 * j] = __builtin_bit_cast(float, gw[j] << 16) * acc[ai][bj][m][j >> 1][2 * (j & 1)]; x[2 * j + 1] = __builtin_bit_cast(float, gw[j] & 0xffff0000u) * acc[ai][bj][m][j >> 1][2 * (j & 1) + 1]; }
                    if (branch > 0) { const u32x4 mw = *(const u32x4*)(mb + off);
#pragma unroll
                        for (int j = 0; j < 4; ++j) { x[2 * j] += __builtin_bit_cast(float, mw[j] << 16); x[2 * j + 1] += __builtin_bit_cast(float, mw[j] & 0xffff0000u); } }
                    u32x4 w; w.x = cvt_pk_bf16(x[0], x[1]); w.y = cvt_pk_bf16(x[2], x[3]); w.z = cvt_pk_bf16(x[4], x[5]); w.w = cvt_pk_bf16(x[6], x[7]);
                    *(u32x4*)(mb + off) = w; } }
    }
};
struct EpiMemKV {
    static constexpr bool PERM = false, AFTER_DRAIN = false, RSTD = false;
    float* outk; size_t kv_stride;
    __device__ __forceinline__ void operator()(const f32x4 (&acc)[2][2][4][2], const Unit& u, int wr, int wc, int fr, int fq) const {
        const int row0 = u.pm * BM + wr * 64 + fr, layer = u.pn >> 2, kv = (u.pn >> 1) & 1, col0 = (u.pn & 1) * BM + wc * 32 + 4 * fq;
        float* base = outk + (size_t)kv * kv_stride + (size_t)layer * 2048 * 512;
#pragma unroll
        for (int ai = 0; ai < 2; ++ai)
#pragma unroll
            for (int m = 0; m < 4; ++m) { const int row = row0 + ai * HALF + m * 16;
#pragma unroll
                for (int bj = 0; bj < 2; ++bj)
#pragma unroll
                    for (int n = 0; n < 2; ++n) *(f32x4*)(base + (size_t)row * 512 + col0 + bj * HALF + n * 16) = acc[ai][bj][m][n]; }
    }
};

struct MultiOrder : StaticOrder {
    int nb, pmstride, pnstride;
    __device__ __forceinline__ bool next(int i, Unit& u) const { Unit b; if (!StaticOrder::next(i / nb, b)) return false; const int g = i % nb; u.pm = b.pm + g * pmstride; u.pn = b.pn + g * pnstride; return true; }
};
struct EpiGateM {
    static constexpr bool PERM = true, AFTER_DRAIN = false, RSTD = false;
    const bf16_t* P; bf16_t* mb;
    __device__ __forceinline__ void operator()(const f32x4 (&acc)[2][2][4][2], const Unit& u, int wr, int wc, int fr, int fq) const {
        const int branch = u.pn >> 2, pn = u.pn & 3, pm = u.pm - 65 * branch;
        const int row0 = pm * BM + wr * 64 + fr, col0 = pn * BM + wc * 32 + 8 * fq;
#pragma unroll
        for (int ai = 0; ai < 2; ++ai) {
            u32x4 gw[4][2], mw[4][2];
#pragma unroll
            for (int m = 0; m < 4; ++m)
#pragma unroll
                for (int bj = 0; bj < 2; ++bj) { const int row = row0 + ai * HALF + m * 16, c = col0 + bj * HALF;
                    gw[m][bj] = *(const u32x4*)(P + (size_t)row * 8960 + 4608 + branch * 1024 + c);
                    mw[m][bj] = (branch > 0) ? *(const u32x4*)(mb + (size_t)row * 1024 + c) : (u32x4){0u, 0u, 0u, 0u}; }
            __builtin_amdgcn_sched_barrier(0);
#pragma unroll
            for (int m = 0; m < 4; ++m) { const int row = row0 + ai * HALF + m * 16;
#pragma unroll
                for (int bj = 0; bj < 2; ++bj) { const int c = col0 + bj * HALF; const size_t off = (size_t)row * 1024 + c;
                    float x[8];
#pragma unroll
                    for (int j = 0; j < 4; ++j) { x[2 * j] = __builtin_bit_cast(float, gw[m][bj][j] << 16) * acc[ai][bj][m][j >> 1][2 * (j & 1)] + __builtin_bit_cast(float, mw[m][bj][j] << 16);
                        x[2 * j + 1] = __builtin_bit_cast(float, gw[m][bj][j] & 0xffff0000u) * acc[ai][bj][m][j >> 1][2 * (j & 1) + 1] + __builtin_bit_cast(float, mw[m][bj][j] & 0xffff0000u); }
                    u32x4 w; w.x = cvt_pk_bf16(x[0], x[1]); w.y = cvt_pk_bf16(x[2], x[3]); w.z = cvt_pk_bf16(x[4], x[5]); w.w = cvt_pk_bf16(x[6], x[7]);
                    *(u32x4*)(mb + off) = w; } }
        }
    }
};
struct EpiPlainM {
    static constexpr bool PERM = true, AFTER_DRAIN = false, RSTD = false;
    bf16_t* O; size_t ostride;
    __device__ __forceinline__ void operator()(const f32x4 (&acc)[2][2][4][2], const Unit& u, int wr, int wc, int fr, int fq) const {
        const int i = u.pn >> 2, pn = u.pn & 3, pm = u.pm - 65 * i; bf16_t* Ob = O + (size_t)i * ostride;
        const int row0 = pm * BM + wr * 64 + fr, col0 = pn * BM + wc * 32 + 8 * fq;
#pragma unroll
        for (int ai = 0; ai < 2; ++ai)
#pragma unroll
            for (int m = 0; m < 4; ++m) { const int row = row0 + ai * HALF + m * 16;
#pragma unroll
                for (int bj = 0; bj < 2; ++bj) { const f32x4 v0 = acc[ai][bj][m][0], v1 = acc[ai][bj][m][1];
                    u32x4 w; w.x = cvt_pk_bf16(v0[0], v0[1]); w.y = cvt_pk_bf16(v0[2], v0[3]); w.z = cvt_pk_bf16(v1[0], v1[1]); w.w = cvt_pk_bf16(v1[2], v1[3]);
                    *(u32x4*)(Ob + (size_t)row * 1024 + col0 + bj * HALF) = w; } }
    }
};
template <class Epi, class Sched, bool ALIGN_EPI = false, bool SP2 = false>
__device__ __forceinline__ void gemm_phase(PG8_LAS unsigned char* lds, const Gemm g, const Sched& S, const Epi& E, int tid_in) {
    int tid_ = tid_in; asm volatile("" : "+v"(tid_)); const int tid = tid_, wid = __builtin_amdgcn_readfirstlane(tid >> 6), lane = tid & 63, wr = wid >> 2, wc = wid & 3, fr = lane & 15, fq = lane >> 4;
    const int K = g.K, nt = K / BK;
    unsigned voffA[2], voffB[2];
#pragma unroll
    for (int i = 0; i < 2; ++i) { int R, C; stage_rc(tid * 16 + i * 8192, R, C); const int Rb = Epi::PERM ? ((R & ~31) + perm32(R & 31)) : R;
        voffA[i] = (unsigned)(R * g.lda + C) * 2u; voffB[i] = (unsigned)(Rb * K + C) * 2u; }
    const size_t kstep = (size_t)(BK * 2);
    const size_t hstepB = (size_t)HALF * K * 2, hstepA = (size_t)HALF * g.lda * 2;
    const size_t tstepA = 2 * hstepA, tstepB = 2 * hstepB;
    const unsigned ldsw = (unsigned)wid * 1024u;
    const int aoff = lds_byte(wr * 64 + fr, fq * 8), boff = lds_byte(wc * 32 + fr, fq * 8);
#define PG8_SA(b, h) (((b) * 2 + (h)) * HTB)
#define PG8_SB(b, h) ((4 + (b) * 2 + (h)) * HTB)
#define PG8_STAGE(bufoff, gbase, voff) do { _Pragma("unroll") for (int _i = 0; _i < 2; ++_i) \
        __builtin_amdgcn_global_load_lds((const unsigned*)((const char*)(gbase) + (voff)[_i]), (PG8_LAS unsigned*)(lds + (bufoff) + ldsw + _i * 8192), 16, 0, 0); } while (0)
#define PG8_LDA(dst, b, h) do { _Pragma("unroll") for (int m = 0; m < 4; ++m) _Pragma("unroll") for (int k = 0; k < 2; ++k) dst[m][k] = *(const PG8_LAS bf16x8*)(lds + PG8_SA(b, h) + aoff + m * 2048 + k * 1024); } while (0)
#define PG8_LDB(dst, b, h) do { _Pragma("unroll") for (int n = 0; n < 2; ++n) _Pragma("unroll") for (int k = 0; k < 2; ++k) dst[n][k] = *(const PG8_LAS bf16x8*)(lds + PG8_SB(b, h) + boff + n * 2048 + k * 1024); } while (0)
#define PG8_MMA(ai, bj, At, Bt) do { __builtin_amdgcn_s_setprio(1); _Pragma("unroll") for (int m = 0; m < 4; ++m) _Pragma("unroll") for (int n = 0; n < 2; ++n) _Pragma("unroll") for (int k = 0; k < 2; ++k) \
        acc[ai][bj][m][n] = __builtin_amdgcn_mfma_f32_16x16x32_bf16(Bt[n][k], At[m][k], acc[ai][bj][m][n], 0, 0, 0); __builtin_amdgcn_s_setprio(0); } while (0)
#define PG8_WAIT_V(n) asm volatile("s_waitcnt vmcnt(" #n ")" ::: "memory")
#define PG8_WAIT_L(n) asm volatile("s_waitcnt lgkmcnt(" #n ")" ::: "memory")
#define PG8_BAR __builtin_amdgcn_s_barrier()
#define PG8_SCHED __builtin_amdgcn_sched_barrier(0)
    Unit cur, nxt; int ui = 0;
    if (!S.next(0, cur)) return;
    f32x4 acc[2][2][4][2];
#pragma unroll
    for (int a = 0; a < 2; ++a)
#pragma unroll
        for (int b = 0; b < 2; ++b)
#pragma unroll
            for (int m = 0; m < 4; ++m)
#pragma unroll
                for (int n = 0; n < 2; ++n) acc[a][b][m][n] = (f32x4){0.f, 0.f, 0.f, 0.f};
    bf16x8 At[4][2], B0[2][2], B1[2][2];
    const char* cA = (const char*)g.A + (size_t)cur.pm * tstepA; const char* cB = (const char*)g.Bt + (size_t)cur.pn * tstepB;
    PG8_LAS float* rtab = (PG8_LAS float*)(lds + 131072 + 1024);
    if constexpr (Epi::RSTD) {
        Unit tu;
        for (int k = 0; S.next(k, tu); ++k)
            if (tid_in < 256) rtab[k * 256 + tid_in] = ep_rstd(E.ssq, tu.pm * BM + tid_in);
        __syncthreads();
    }
    S.a_ready(cur);
    if constexpr (SP2) {
        PG8_STAGE(PG8_SB(0, 0), cB, voffB); PG8_STAGE(PG8_SB(0, 1), cB + hstepB, voffB); PG8_STAGE(PG8_SA(0, 0), cA, voffA); PG8_STAGE(PG8_SA(0, 1), cA + hstepA, voffA);
        if (wr == 1) PG8_BAR;
        PG8_WAIT_V(2); PG8_BAR;
        PG8_STAGE(PG8_SB(1, 0), cB + kstep, voffB); PG8_STAGE(PG8_SA(1, 0), cA + kstep, voffA); PG8_STAGE(PG8_SB(1, 1), cB + hstepB + kstep, voffB);
        PG8_WAIT_V(6); PG8_BAR;
    } else {
        PG8_STAGE(PG8_SB(0, 0), cB, voffB); PG8_STAGE(PG8_SA(0, 0), cA, voffA); PG8_STAGE(PG8_SB(0, 1), cB + hstepB, voffB); PG8_STAGE(PG8_SA(0, 1), cA + hstepA, voffA);
        if (wr == 1) PG8_BAR;
        PG8_WAIT_V(4); PG8_BAR;
        PG8_STAGE(PG8_SB(1, 0), cB + kstep, voffB); PG8_STAGE(PG8_SA(1, 0), cA + kstep, voffA); PG8_STAGE(PG8_SB(1, 1), cB + hstepB + kstep, voffB);
        PG8_WAIT_V(6); PG8_BAR;
    }
    for (;;) {
        const bool has_next = S.next(ui + 1, nxt);
        const char* nA = has_next ? (const char*)g.A + (size_t)nxt.pm * tstepA : cA; const char* nB = has_next ? (const char*)g.Bt + (size_t)nxt.pn * tstepB : cB;
        for (int t = 0; t < nt; t += 2) {
            const bool last = (t == nt - 2);
            const char* a1 = cA + (size_t)(t + 1) * kstep;
            const char* a2 = last ? nA : cA + (size_t)(t + 2) * kstep; const char* b2 = last ? nB : cB + (size_t)(t + 2) * kstep;
            const char* a3 = a2 + kstep; const char* b3 = b2 + kstep;
            if (last && has_next) S.a_ready(nxt);
            if constexpr (SP2) {
            PG8_LDB(B0, 0, 0); PG8_LDB(B1, 0, 1); PG8_SCHED; PG8_LDA(At, 0, 0); PG8_STAGE(PG8_SA(1, 1), a1 + hstepA, voffA);
            PG8_WAIT_V(8); PG8_WAIT_L(0); PG8_BAR; PG8_MMA(0, 0, At, B0); PG8_MMA(0, 1, At, B1); PG8_BAR; PG8_SCHED;
            PG8_LDA(At, 0, 1); PG8_STAGE(PG8_SB(0, 0), b2, voffB); PG8_STAGE(PG8_SB(0, 1), b2 + hstepB, voffB); PG8_STAGE(PG8_SA(0, 0), a2, voffA);
            PG8_WAIT_V(8); PG8_WAIT_L(0); PG8_BAR; PG8_MMA(1, 0, At, B0); PG8_MMA(1, 1, At, B1); PG8_BAR; PG8_SCHED;
            PG8_LDB(B0, 1, 0); PG8_LDB(B1, 1, 1); PG8_SCHED; PG8_LDA(At, 1, 0); PG8_STAGE(PG8_SA(0, 1), a2 + hstepA, voffA);
            PG8_WAIT_V(8); PG8_WAIT_L(0); PG8_BAR; PG8_MMA(0, 0, At, B0); PG8_MMA(0, 1, At, B1); PG8_BAR; PG8_SCHED;
            PG8_LDA(At, 1, 1); PG8_STAGE(PG8_SB(1, 0), b3, voffB); PG8_STAGE(PG8_SB(1, 1), b3 + hstepB, voffB); PG8_STAGE(PG8_SA(1, 0), a3, voffA);
            PG8_WAIT_V(8); PG8_WAIT_L(0); PG8_BAR; PG8_MMA(1, 0, At, B0); PG8_MMA(1, 1, At, B1); PG8_BAR; PG8_SCHED;
            } else {
            PG8_LDB(B0, 0, 0); PG8_SCHED; PG8_LDA(At, 0, 0); PG8_STAGE(PG8_SA(1, 1), a1 + hstepA, voffA);
            PG8_WAIT_L(8); PG8_BAR; PG8_WAIT_L(0); PG8_MMA(0, 0, At, B0); PG8_BAR; PG8_SCHED;
            PG8_LDB(B1, 0, 1); PG8_STAGE(PG8_SB(0, 0), b2, voffB);
            PG8_BAR; PG8_WAIT_L(0); PG8_MMA(0, 1, At, B1); PG8_BAR;
            PG8_LDA(At, 0, 1); PG8_STAGE(PG8_SA(0, 0), a2, voffA);
            PG8_BAR; PG8_WAIT_L(0); PG8_MMA(1, 0, At, B0); PG8_BAR; PG8_SCHED;
            PG8_STAGE(PG8_SB(0, 1), b2 + hstepB, voffB);
            PG8_WAIT_V(6); PG8_BAR; PG8_MMA(1, 1, At, B1); PG8_BAR;
            PG8_LDB(B0, 1, 0); PG8_SCHED; PG8_LDA(At, 1, 0); PG8_STAGE(PG8_SA(0, 1), a2 + hstepA, voffA);
            PG8_WAIT_L(8); PG8_BAR; PG8_WAIT_L(0); PG8_MMA(0, 0, At, B0); PG8_BAR; PG8_SCHED;
            PG8_LDB(B1, 1, 1); PG8_STAGE(PG8_SB(1, 0), b3, voffB);
            PG8_BAR; PG8_WAIT_L(0); PG8_MMA(0, 1, At, B1); PG8_BAR;
            PG8_LDA(At, 1, 1); PG8_STAGE(PG8_SA(1, 0), a3, voffA);
            PG8_BAR; PG8_WAIT_L(0); PG8_MMA(1, 0, At, B0); PG8_BAR; PG8_SCHED;
            PG8_STAGE(PG8_SB(1, 1), b3 + hstepB, voffB);
            PG8_WAIT_V(6); PG8_BAR; PG8_MMA(1, 1, At, B1); PG8_BAR;
            }
        }
        if constexpr (ALIGN_EPI) { if (wr == 0) PG8_BAR; }
        if constexpr (Epi::RSTD) { float rsv[2][4];
            _Pragma("unroll") for (int ai = 0; ai < 2; ++ai) _Pragma("unroll") for (int m = 0; m < 4; ++m) rsv[ai][m] = rtab[ui * 256 + wr * 64 + fr + ai * 128 + m * 16];
            E(acc, cur, wr, wc, fr, fq, rsv); S.done(cur); }
        else if constexpr (!Epi::AFTER_DRAIN) { E(acc, cur, wr, wc, fr, fq); S.done(cur); }
        if (!has_next) break;
#pragma unroll
        for (int a = 0; a < 2; ++a)
#pragma unroll
            for (int b = 0; b < 2; ++b)
#pragma unroll
                for (int m = 0; m < 4; ++m)
#pragma unroll
                    for (int n = 0; n < 2; ++n) acc[a][b][m][n] = (f32x4){0.f, 0.f, 0.f, 0.f};
        cur = nxt; cA = nA; cB = nB; ++ui;
        if constexpr (ALIGN_EPI) { if (wr == 1) PG8_BAR; }
    }
    PG8_WAIT_V(0);
    if constexpr (!ALIGN_EPI) { if (wr == 0) PG8_BAR; }
    PG8_BAR;
    if constexpr (Epi::AFTER_DRAIN) { E.fused(acc, cur, wr, wc, fr, fq, lds, wid, lane); S.done(cur); }
#undef PG8_SA
#undef PG8_SB
#undef PG8_STAGE
#undef PG8_LDA
#undef PG8_LDB
#undef PG8_MMA
#undef PG8_WAIT_V
#undef PG8_WAIT_L
#undef PG8_BAR
#undef PG8_SCHED
}
}
#define XB_TMO      128
#define XB_XCNT(j)  (256  + 64 * (j))
#define XB_XSUB(j)  (1280 + 64 * (j))
#define XB_XGEN(j)  (2304 + 64 * (j))
#define XB_TOP      3328
#define XB_TOPGEN   3392
#define XCD_BAR_WORDS 3456
#define XB_SPIN_CAP (1u << 18)
#define LAS __attribute__((address_space(3)))

__device__ __forceinline__ unsigned xb_ld(unsigned* p)              { return __hip_atomic_load(p, __ATOMIC_RELAXED, __HIP_MEMORY_SCOPE_AGENT); }
__device__ __forceinline__ unsigned xb_add(unsigned* p, unsigned v) { return __hip_atomic_fetch_add(p, v, __ATOMIC_RELAXED, __HIP_MEMORY_SCOPE_AGENT); }
__device__ __forceinline__ unsigned xb_xcc_id() { return (unsigned)__builtin_amdgcn_s_getreg((3 << 11) | 20) & 0xFu; }
#define XB_SPIN(cond, bar) do { unsigned _sp = 0; while (cond) { __builtin_amdgcn_s_sleep(1); \
    if ((++_sp & 255u) == 0u) { if (xb_ld(&(bar)[XB_TMO])) break; if (_sp > XB_SPIN_CAP) { atomicAdd(&(bar)[XB_TMO], 1u); break; } } } } while (0)

__device__ __forceinline__ int xb_lane_id() { return (int)__builtin_amdgcn_mbcnt_hi(~0u, __builtin_amdgcn_mbcnt_lo(~0u, 0u)); }
struct XcdBarrier {
    int w0; unsigned* bar; unsigned x;
    volatile LAS unsigned* st;
};

__device__ __forceinline__ XcdBarrier xcd_barrier_post(unsigned* bar, volatile LAS unsigned* st, int w0) {
    XcdBarrier b; b.w0 = w0; b.bar = bar; b.x = xb_xcc_id(); b.st = st;
    if (b.w0 == 0 && xb_lane_id() == 0) (void)xb_add(&bar[XB_XCNT(b.x)], 1u);
    return b;
}
__device__ __forceinline__ void xcd_barrier_complete(unsigned* bar, unsigned x, unsigned& nloc, unsigned& nx) {
    const unsigned G = gridDim.x * gridDim.y * gridDim.z;
    unsigned sum, cnt, mine, sp = 0u;
    for (;;) {
        sum = 0u; cnt = 0u; mine = 0u;
#pragma unroll
        for (unsigned j = 0; j < 16; ++j) { const unsigned c = xb_ld(&bar[XB_XCNT(j)]); sum += c; cnt += (c > 0u) ? 1u : 0u; mine = (j == x) ? c : mine; }
        if (sum == G) break;
        __builtin_amdgcn_s_sleep(1);
        if ((++sp & 255u) == 0u) { if (xb_ld(&bar[XB_TMO])) break; if (sp > XB_SPIN_CAP) { atomicAdd(&bar[XB_TMO], 1u); break; } }
    }
    nloc = mine > 0u ? mine : 1u; nx = cnt > 0u ? cnt : 1u;
}

__device__ __forceinline__ void xcd_barrier(const XcdBarrier& b) {
    asm volatile("s_waitcnt vmcnt(0)" ::: "memory");
    __syncthreads();
    if (b.w0 == 0 && xb_lane_id() == 0) {
        unsigned* bar = b.bar;
        __builtin_amdgcn_s_waitcnt(0);
        unsigned nloc = b.st[0], nx = b.st[1];
        if (nloc == 0u) { xcd_barrier_complete(bar, b.x, nloc, nx); b.st[0] = nloc; b.st[1] = nx; }
        const unsigned old = xb_add(&bar[XB_XSUB(b.x)], 1u);
        const unsigned gen = old / nloc;
        if (old + 1u == (gen + 1u) * nloc) {
            __builtin_amdgcn_fence(__ATOMIC_RELEASE, "agent");
            asm volatile("s_waitcnt vmcnt(0)" ::: "memory");
            const unsigned og = xb_add(&bar[XB_TOP], 1u);
            const unsigned tg = og / nx;
            if (og + 1u == (tg + 1u) * nx) xb_add(&bar[XB_TOPGEN], 1u);
            else XB_SPIN(xb_ld(&bar[XB_TOPGEN]) == tg, bar);
            __builtin_amdgcn_fence(__ATOMIC_ACQUIRE, "agent");
            xb_add(&bar[XB_XGEN(b.x)], 1u);
            asm volatile("s_waitcnt vmcnt(0)" ::: "memory");
        } else {
            XB_SPIN(xb_ld(&bar[XB_XGEN(b.x)]) == gen, bar);
            __builtin_amdgcn_fence(__ATOMIC_ACQUIRE, "agent");
            asm volatile("s_waitcnt vmcnt(0)" ::: "memory");
        }
    }
    __syncthreads();
}

struct Args {
    const float* in[39]; const int* page_table; float* out; unsigned char* ws; int ph_lo, ph_hi;
};
struct Frame {
    LAS unsigned char* lds;
    int tid, lane, wave, G, bid, wave0;
    const float* const* in; const int* page_table; float* out; unsigned char* ws;
};
template <class T> __device__ __forceinline__ T* launder_ptr(T* p) {
    unsigned lo = (unsigned)(unsigned long long)p, hi = (unsigned)((unsigned long long)p >> 32); asm volatile("" : "+v"(lo), "+v"(hi));
    lo = __builtin_amdgcn_readfirstlane(lo); hi = __builtin_amdgcn_readfirstlane(hi); return (T*)(GAS T*)(((unsigned long long)hi << 32) | lo);
}
__device__ __forceinline__ int launder_int(int x) { asm volatile("" : "+v"(x)); return __builtin_amdgcn_readfirstlane(x); }
__device__ __forceinline__ void launder(Frame& F) {
    int t = F.wave0 * 64 + (int)__builtin_amdgcn_mbcnt_hi(~0u, __builtin_amdgcn_mbcnt_lo(~0u, 0u)); asm volatile("" : "+v"(t)); F.tid = t; F.lane = t & 63; F.wave = __builtin_amdgcn_readfirstlane(t >> 6);
    F.ws = launder_ptr(F.ws); F.out = launder_ptr(F.out); F.in = launder_ptr(F.in); F.page_table = launder_ptr(F.page_table);
    F.G = launder_int((int)gridDim.x); F.bid = launder_int((int)blockIdx.x);
}
#define LDS_WAIT() asm volatile("s_waitcnt lgkmcnt(0)" ::: "memory")
#define INP(k) ((const float*)(const GAS float*)(F.in[k]))
#define AIN(k) ((const float*)(const GAS float*)(args.in[k]))
template <class T> __device__ __forceinline__ T* wsp(const Frame& F, size_t off) { return (T*)(F.ws + off); }
__device__ __forceinline__ bf16* wl(const Frame& F, int L, size_t off) { return (bf16*)(F.ws + WS_W + (size_t)L * WL_SIZE + off); }
__device__ __forceinline__ float* ssqbuf(const Frame& F, int i) { return (float*)(F.ws + WS_SSQ) + (size_t)i * MT * 16; }

template <class CM>
__device__ __forceinline__ void transpose_item(const float* W, int K, int N, bf16* WT, const float* gain, LAS float* scr, int item, int lane, int ndst, CM cmap) {
    const int nblk = ndst / 32, kb = item / nblk, nb = item % nblk, k0 = 64 * kb, n0 = 32 * nb;
    const int sc = cmap(n0 + (lane & 31));
    {
        float v[32];
#pragma unroll
        for (int i = 0; i < 32; ++i) { const int kk = 2 * i + (lane >> 5); v[i] = (sc >= 0) ? W[(size_t)(k0 + kk) * N + sc] : 0.f; }
        if (gain) {
#pragma unroll
            for (int i = 0; i < 32; ++i) v[i] *= gain[k0 + 2 * i + (lane >> 5)]; }
#pragma unroll
        for (int i = 0; i < 32; ++i) scr[(2 * i + (lane >> 5)) * 33 + (lane & 31)] = v[i];
    }
    LDS_WAIT(); asm volatile("" ::: "memory");
    const int c = lane & 7;
#pragma unroll
    for (int j = 0; j < 4; ++j) { const int n = (lane >> 3) + 8 * j; const LAS float* s = scr + (8 * c) * 33 + n;
        v4u o; o.x = pk2(s[0 * 33], s[1 * 33]); o.y = pk2(s[2 * 33], s[3 * 33]); o.z = pk2(s[4 * 33], s[5 * 33]); o.w = pk2(s[6 * 33], s[7 * 33]);
        *(v4u*)(WT + (size_t)(n0 + n) * K + k0 + 8 * c) = o; }
    LDS_WAIT(); asm volatile("" ::: "memory");
}
struct CmId { __device__ int operator()(int n) const { return n; } };
struct CmGu { __device__ int operator()(int n) const { return ((n >> 7) & 1) * 2816 + (n >> 8) * 128 + (n & 127); } };
struct CmQb { __device__ int operator()(int n) const { return n < 768 ? n : -1; } };
struct CmIn { __device__ int operator()(int n) const { return n < 2048 ? n : (n < 4096 ? n + 8 : (n < 8704 ? n + 40 : (n < 8736 ? n - 4600 : (n < 8744 ? n - 6688 : -1)))); } };

#define W_ITEM(PTR, L, r_) do { int r = (r_); \
        if (r < I_GU) { transpose_item(PTR(12) + (size_t)(L) * 1024 * 5632, 1024, 5632, wl(F, L, WL_GU1), PTR(11) + (L) * 1024, scr, r, F.lane, 5632, CmGu()); break; } r -= I_GU; \
        if (r < I_GU) { transpose_item(PTR(37) + (size_t)(L) * 1024 * 5632, 1024, 5632, wl(F, L, WL_GU2), PTR(36) + (L) * 1024, scr, r, F.lane, 5632, CmGu()); break; } r -= I_GU; \
        if (r < I_D) { transpose_item(PTR(13) + (size_t)(L) * 2816 * 1024, 2816, 1024, wl(F, L, WL_D1), nullptr, scr, r, F.lane, 1024, CmId()); break; } r -= I_D; \
        if (r < I_D) { transpose_item(PTR(38) + (size_t)(L) * 2816 * 1024, 2816, 1024, wl(F, L, WL_D2), nullptr, scr, r, F.lane, 1024, CmId()); break; } r -= I_D; \
        if (r < I_IN) { transpose_item(PTR(15) + (size_t)(L) * 1024 * NIN, 1024, NIN, wl(F, L, WL_IN), PTR(14) + (L) * 1024, scr, r, F.lane, NINP, CmIn()); break; } r -= I_IN; \
        if (r < I_O4) { transpose_item(PTR(20) + (size_t)(L) * 512 * 1024, 512, 1024, wl(F, L, WL_DNO), nullptr, scr, r, F.lane, 1024, CmId()); break; } r -= I_O4; \
        if (r < I_O4) { transpose_item(PTR(22) + (size_t)(L) * 512 * 1024, 512, 1024, wl(F, L, WL_SCO), nullptr, scr, r, F.lane, 1024, CmId()); break; } r -= I_O4; \
        if (r < I_O4) { transpose_item(PTR(29) + (size_t)(L) * 512 * 1024, 512, 1024, wl(F, L, WL_MLAO), nullptr, scr, r, F.lane, 1024, CmId()); break; } r -= I_O4; \
        if (r < I_O4) { transpose_item(PTR(34) + (size_t)(L) * 512 * 1024, 512, 1024, wl(F, L, WL_MEMO), nullptr, scr, r, F.lane, 1024, CmId()); break; } r -= I_O4; \
        if (r < I_QB) { transpose_item(PTR(24) + (size_t)(L) * 256 * 768, 256, 768, wl(F, L, WL_QB), PTR(23) + (L) * 256, scr, r, F.lane, 1024, CmQb()); break; } r -= I_QB; \
        if (r < I_KVB) { transpose_item(PTR(26) + (size_t)(L) * 256 * 1024, 256, 1024, wl(F, L, WL_KVB), nullptr, scr, r, F.lane, 1024, CmId()); break; } r -= I_KVB; \
        if (r < I_WO) { transpose_item(PTR(35) + (size_t)(L) * 1024 * 1024, 1024, 1024, wl(F, L, WL_WO), nullptr, scr, r, F.lane, 1024, CmId()); break; } r -= I_WO; \
        transpose_item(PTR(31) + (size_t)(L) * 1024 * 1024, 1024, 1024, wsp<bf16>(F, WS_WMEMKV) + (size_t)(L) * 1024 * 1024, PTR(30) + (L) * 1024, scr, r, F.lane, 1024, CmId()); } while (0)
constexpr int I_GU = 16 * 176, I_D = 44 * 32, I_IN = 16 * 280, I_O4 = 8 * 32, I_QB = 4 * 32, I_KVB = 4 * 32, I_WO = 16 * 32, I_MKV = 16 * 32;
constexpr int PER_L = 2 * I_GU + 2 * I_D + I_IN + 4 * I_O4 + I_QB + I_KVB + I_WO + I_MKV, PER_L1 = PER_L - I_MKV;
__device__ __forceinline__ void p0_weights(Frame& F, const Args& args, bool defer1) {
    LAS float* scr = (LAS float*)(F.lds + F.wave * 16384);
    const int gw = F.bid * NWAVES + F.wave, NGW = F.G * NWAVES;
    const int total = defer1 ? PER_L + I_MKV : 2 * PER_L;
    for (int it = gw; it < total; it += NGW) {
        if (it < PER_L) W_ITEM(AIN, 0, it);
        else if (defer1) W_ITEM(AIN, 1, PER_L1 + (it - PER_L));
        else W_ITEM(AIN, 1, it - PER_L);
    }
}
__device__ __forceinline__ void w1_fill(Frame& F, int vb, int vG, int i0, int i1) {
    LAS float* scr = (LAS float*)(F.lds + F.wave * 16384);
    for (int it = i0 + vb * NWAVES + F.wave; it < i1; it += vG * NWAVES) W_ITEM(INP, 1, it);
}
__device__ const float ROPE_INV[16] = {1.0f, 0.562341332f, 0.316227764f, 0.177827939f, 0.100000001f, 0.0562341325f, 0.0316227749f, 0.0177827943f, 0.00999999978f, 0.00562341325f, 0.00316227763f, 0.00177827943f, 0.00100000005f, 0.000562341302f, 0.000316227757f, 0.00017782794f};
__device__ __forceinline__ void p0_rows(Frame& F, const Args& args) {
    const int gw = F.bid * NWAVES + F.wave, NGW = F.G * NWAVES, lane = F.lane;
    float* X = wsp<float>(F, WS_X); bf16* XB = wsp<bf16>(F, WS_XB); float* ssq0 = ssqbuf(F, 0);
    for (int m = gw; m < MT; m += NGW) {
        f32x4 v[4]; float s = 0.f;
        const float* src = m < MP ? AIN(0) + (size_t)m * D : (m < MV ? AIN(1) + (size_t)(m - MP) * D : nullptr);
#pragma unroll
        for (int j = 0; j < 4; ++j) { v[j] = src ? *(const f32x4*)(src + 4 * lane + 256 * j) : (f32x4){0.f, 0.f, 0.f, 0.f}; s += (v[j][0] * v[j][0] + v[j][1] * v[j][1]) + (v[j][2] * v[j][2] + v[j][3] * v[j][3]); }
        s = wave_sum(s);
#pragma unroll
        for (int j = 0; j < 4; ++j) { *(f32x4*)(X + (size_t)m * D + 4 * lane + 256 * j) = v[j]; v2u w; w.x = pk2(v[j][0], v[j][1]); w.y = pk2(v[j][2], v[j][3]); *(v2u*)(XB + (size_t)m * D + 4 * lane + 256 * j) = w; }
        if (lane < 16) ssq0[(size_t)m * 16 + lane] = lane == 0 ? s : 0.f;
    }
    bf16* MEMB = wsp<bf16>(F, WS_MEMB);
    for (int m = gw; m < 2048; m += NGW) {
        f32x4 v[4]; float s = 0.f; const float* src = AIN(10) + (size_t)m * D;
#pragma unroll
        for (int j = 0; j < 4; ++j) { v[j] = *(const f32x4*)(src + 4 * lane + 256 * j); s += (v[j][0] * v[j][0] + v[j][1] * v[j][1]) + (v[j][2] * v[j][2] + v[j][3] * v[j][3]); }
        s = wave_sum(s); const float rs = rsq_f(s * (1.0f / 1024.0f) + EPS);
#pragma unroll
        for (int j = 0; j < 4; ++j) { v2u w; w.x = pk2(v[j][0] * rs, v[j][1] * rs); w.y = pk2(v[j][2] * rs, v[j][3] * rs); *(v2u*)(MEMB + (size_t)m * D + 4 * lane + 256 * j) = w; }
    }
    float* rope = wsp<float>(F, WS_ROPE);
    for (int i = F.bid * 512 + F.tid; i < 2052 * 16; i += F.G * 512) {
        const int p = i >> 4, k = i & 15; const int pos = p < 2048 ? p : 16384 + (p - 2048);
        const float ang = (float)pos * ROPE_INV[k];
        rope[p * 32 + k] = cosf(ang); rope[p * 32 + 16 + k] = sinf(ang);
    }
    bf16* MK = wsp<bf16>(F, WS_MK); bf16* MVT = wsp<bf16>(F, WS_MVT);
    for (int i = F.bid * 512 + F.tid; i < 2 * 32 * 256 * 4 * 16; i += F.G * 512) {
        const int c8 = i & 15, h = (i >> 4) & 3, m = (i >> 6) & 255, db = (i >> 14) & 31, l = i >> 19;
        const float* src = AIN(7) + ((((size_t)l * 32 + db) * 256 + m) * 4 + h) * 128 + c8 * 8;
        const f32x4 a = *(const f32x4*)src, b = *(const f32x4*)(src + 4);
        v4u w; w.x = pk2(a[0], a[1]); w.y = pk2(a[2], a[3]); w.z = pk2(b[0], b[1]); w.w = pk2(b[2], b[3]);
        *(v4u*)(MK + ((((size_t)l * NSEQ + 8 + db) * 4 + h) * 256 + m) * 128 + c8 * 8) = w;
    }
    for (int i = F.bid * 512 + F.tid; i < 2 * 32 * 4 * 128 * 32; i += F.G * 512) {
        const int d = i & 127, m8 = (i >> 7) & 31, h = (i >> 12) & 3, db = (i >> 14) & 31, l = i >> 19;
        float f[8];
#pragma unroll
        for (int j = 0; j < 8; ++j) f[j] = AIN(8)[((((size_t)l * 32 + db) * 256 + m8 * 8 + j) * 4 + h) * 128 + d];
        *(v4u*)(MVT + ((((size_t)l * NSEQ + 8 + db) * 4 + h) * 128 + d) * 256 + m8 * 8) = pack8(f);
    }
}
__device__ __forceinline__ void p2_memkv_post(Frame& F, int vb, int vG) {
    const int gw = vb * NWAVES + F.wave, NGW = vG * NWAVES, lane = F.lane;
    bf16* MK = wsp<bf16>(F, WS_MK); bf16* MVT = wsp<bf16>(F, WS_MVT);
    for (int r = gw; r < 2 * 2048; r += NGW) {
        const int l = r >> 11, bm = r & 2047, b = bm >> 8, m = bm & 255, h = lane >> 4, c = (lane & 15) * 8;
        float* kp = F.out + O_PMK + (size_t)r * 512 + lane * 8;
        f32x4 a = *(const f32x4*)kp, bb = *(const f32x4*)(kp + 4);
        float s = (a[0] * a[0] + a[1] * a[1]) + (a[2] * a[2] + a[3] * a[3]) + (bb[0] * bb[0] + bb[1] * bb[1]) + (bb[2] * bb[2] + bb[3] * bb[3]);
        s = sum16(s); const float rs = rsq_f(s * (1.0f / 128.0f) + EPS);
        const float* gn = INP(33) + l * 128 + c;
        float f[8];
#pragma unroll
        for (int j = 0; j < 4; ++j) { f[j] = a[j] * rs * gn[j]; f[4 + j] = bb[j] * rs * gn[4 + j]; }
        *(f32x4*)kp = (f32x4){f[0], f[1], f[2], f[3]}; *(f32x4*)(kp + 4) = (f32x4){f[4], f[5], f[6], f[7]};
        *(v4u*)(MK + ((((size_t)l * NSEQ + b) * 4 + h) * 256 + m) * 128 + c) = pack8(f);
    }
    for (int i = vb * 512 + F.tid; i < 2 * 8 * 4 * 128 * 32; i += vG * 512) {
        const int d = i & 127, m8 = (i >> 7) & 31, h = (i >> 12) & 3, b = (i >> 14) & 7, l = i >> 17;
        float f[8];
#pragma unroll
        for (int j = 0; j < 8; ++j) f[j] = F.out[O_PMV + (((size_t)l * 8 + b) * 256 + m8 * 8 + j) * 512 + h * 128 + d];
        *(v4u*)(MVT + ((((size_t)l * NSEQ + b) * 4 + h) * 128 + d) * 256 + m8 * 8) = pack8(f);
    }
}

#define PREP_STAGE3() do { \
        _Pragma("unroll") for (int r = 0; r < 4; ++r) { mq[r] = *(const v2u*)(P0 + (size_t)r * NINP + PC_MQ + 4 * lane); mk[r] = *(const v2u*)(P0 + (size_t)r * NINP + PC_MKV + 4 * lane); mm[r] = *(const v4u*)(P0 + (size_t)r * NINP + PC_MEMQ + 8 * lane); } \
        { const int r = lane >> 4, kk = lane & 15; const size_t row = row0 + r; const int pp = smp ? 2048 + t0 + r : t0 + r; \
          rx1 = SIDE[row * 64 + kk]; rx2 = SIDE[row * 64 + 16 + kk]; rcs = rope[pp * 32 + kk]; rsn = rope[pp * 32 + 16 + kk]; } } while (0)
__device__ __forceinline__ void prep_rows(Frame& F, int L) {
    const int gw = F.bid * NWAVES + F.wave, NGW = F.G * NWAVES, lane = F.lane;
    const bf16* P = wsp<bf16>(F, WS_P); const float* SIDE = wsp<float>(F, WS_SIDE);
    bf16* QKVN = wsp<bf16>(F, WS_QKVN); float* GB = wsp<float>(F, WS_GB); bf16* OSC = wsp<bf16>(F, WS_OSC);
    bf16* CQB = wsp<bf16>(F, WS_CQB); bf16* CKVB = wsp<bf16>(F, WS_CKVB); float* KRB = wsp<float>(F, WS_KRB); bf16* QMB = wsp<bf16>(F, WS_QMB);
    const float* rope = wsp<float>(F, WS_ROPE);
    const float* dnw = INP(16) + (size_t)L * 4 * 1536; const float* scw = INP(21) + (size_t)L * 3 * 512;
    for (int wi = gw; wi < MP / 4 + 7 * (MS / 4); wi += NGW) {
        const int sidx = wi - MP / 4; const int grp = sidx < 0 ? wi : MP / 4 + sidx / 7; const int mask = sidx < 0 ? 0x7F : 1 << (sidx % 7);
        const int row0 = grp * 4; const bool smp = row0 >= MP; const int sq = smp ? (row0 - MP) >> 2 : row0 >> 11; const int t0 = smp ? 0 : row0 & 2047; const int T = smp ? 4 : 2048;
        const bf16* P0 = P + (size_t)row0 * NINP;
        const bool hist = t0 > 0;
        v2u mq[4], mk[4]; v4u mm[4]; float rx1, rx2, rcs, rsn;
#pragma unroll 1
        for (int i = 0; i < 3; ++i) {
            if (!((mask >> i) & 1)) continue;
            const int c = 512 * i + 8 * lane; float x[7][8], wv[4][8];
#pragma unroll
            for (int k = 0; k < 7; ++k) {
                if (k >= 3 || t0 > 0) unpack8(*(const v4u*)(P0 + (ptrdiff_t)(k - 3) * NINP + c), x[k]);
                else if (smp) { const float* pv = INP(3) + (((size_t)L * 32 + sq) * 3 + k) * 1536 + c; const f32x4 a = *(const f32x4*)pv, bq = *(const f32x4*)(pv + 4);
#pragma unroll
                    for (int j = 0; j < 4; ++j) { x[k][j] = a[j]; x[k][4 + j] = bq[j]; } }
                else {
#pragma unroll
                    for (int j = 0; j < 8; ++j) x[k][j] = 0.f; }
            }
#pragma unroll
            for (int jj = 0; jj < 4; ++jj) { const f32x4 wa = *(const f32x4*)(dnw + jj * 1536 + c), wb = *(const f32x4*)(dnw + jj * 1536 + c + 4);
#pragma unroll
                for (int j = 0; j < 4; ++j) { wv[jj][j] = wa[j]; wv[jj][4 + j] = wb[j]; } }
#pragma unroll
            for (int r = 0; r < 4; ++r) {
                float acc[8];
#pragma unroll
                for (int j = 0; j < 8; ++j) acc[j] = (x[r][j] * wv[0][j] + x[r + 1][j] * wv[1][j]) + (x[r + 2][j] * wv[2][j] + x[r + 3][j] * wv[3][j]);
                if (t0 + r >= T - 3) {
                    float* o = F.out + (smp ? O_SDNC + (((size_t)L * 32 + sq) * 3 + (t0 + r - (T - 3))) * 1536 : O_PDNC + (((size_t)L * 8 + sq) * 3 + (t0 + r - (T - 3))) * 1536) + c;
                    *(f32x4*)o = (f32x4){x[r + 3][0], x[r + 3][1], x[r + 3][2], x[r + 3][3]}; *(f32x4*)(o + 4) = (f32x4){x[r + 3][4], x[r + 3][5], x[r + 3][6], x[r + 3][7]};
                }
                float ss = 0.f;
#pragma unroll
                for (int j = 0; j < 8; ++j) { acc[j] = silu_f(acc[j]); ss += acc[j] * acc[j]; }
                if (i < 2) { ss = sum16(ss); const float rs = rsq_f(ss + EPS);
#pragma unroll
                    for (int j = 0; j < 8; ++j) acc[j] *= rs; }
                *(v4u*)(QKVN + (size_t)(row0 + r) * 1536 + c) = pack8(acc);
            }
        }
        if ((mask & 8) && lane < 16) { const int r = lane >> 2, hh = lane & 3; const size_t row = row0 + r; const float a = SIDE[row * 64 + 32 + hh], bq = SIDE[row * 64 + 36 + hh];
            const float xs = a + INP(18)[L * 4 + hh]; const float ex = fexp2(xs * LOG2E);
            const float sp = xs > 15.f ? xs : (ex < 1e-4f ? ex * (1.0f - 0.5f * ex) : __log2f(1.0f + ex) * 0.6931471805599453f);
            GB[row * 8 + hh] = -fexp2(INP(17)[L * 4 + hh] * LOG2E) * sp; GB[row * 8 + 4 + hh] = sigmoid_f(bq); }
        if (mask & 16) {
            const int c = 8 * lane; float u[6][8], wv[3][8], bv[4][8];
#pragma unroll
            for (int k = 0; k < 6; ++k) {
                if (k >= 2 || t0 > 0) { float cv[8], xv[8]; unpack8(*(const v4u*)(P0 + (ptrdiff_t)(k - 2) * NINP + PC_SCC + c), cv); unpack8(*(const v4u*)(P0 + (ptrdiff_t)(k - 2) * NINP + PC_SCX + c), xv);
#pragma unroll
                    for (int j = 0; j < 8; ++j) u[k][j] = cv[j] * xv[j]; }
                else if (smp) { const float* pv = INP(4) + (((size_t)L * 32 + sq) * 2 + k) * 512 + c; const f32x4 a = *(const f32x4*)pv, bq = *(const f32x4*)(pv + 4);
#pragma unroll
                    for (int j = 0; j < 4; ++j) { u[k][j] = a[j]; u[k][4 + j] = bq[j]; } }
                else {
#pragma unroll
                    for (int j = 0; j < 8; ++j) u[k][j] = 0.f; }
            }
#pragma unroll
            for (int r = 0; r < 4; ++r) unpack8(*(const v4u*)(P0 + (size_t)r * NINP + PC_SCB + c), bv[r]);
            if (mask & 0x60) PREP_STAGE3();
#pragma unroll
            for (int jj = 0; jj < 3; ++jj) { const f32x4 wa = *(const f32x4*)(scw + jj * 512 + c), wb = *(const f32x4*)(scw + jj * 512 + c + 4);
#pragma unroll
                for (int j = 0; j < 4; ++j) { wv[jj][j] = wa[j]; wv[jj][4 + j] = wb[j]; } }
#pragma unroll
            for (int r = 0; r < 4; ++r) {
                float acc[8];
#pragma unroll
                for (int j = 0; j < 8; ++j) acc[j] = ((u[r][j] * wv[0][j] + u[r + 1][j] * wv[1][j]) + u[r + 2][j] * wv[2][j]) * bv[r][j];
                if (t0 + r >= T - 2) {
                    float* o = F.out + (smp ? O_SSCC + (((size_t)L * 32 + sq) * 2 + (t0 + r - (T - 2))) * 512 : O_PSCC + (((size_t)L * 8 + sq) * 2 + (t0 + r - (T - 2))) * 512) + c;
                    *(f32x4*)o = (f32x4){u[r + 2][0], u[r + 2][1], u[r + 2][2], u[r + 2][3]}; *(f32x4*)(o + 4) = (f32x4){u[r + 2][4], u[r + 2][5], u[r + 2][6], u[r + 2][7]};
                }
                *(v4u*)(OSC + (size_t)(row0 + r) * 512 + c) = pack8(acc);
            }
        }
        else if (mask & 0x60) PREP_STAGE3();
        if (mask & 32) {
            const int c = 4 * lane; float q[4][4], k[4][4], sq2[4], sk2[4];
#pragma unroll
            for (int r = 0; r < 4; ++r) { const v2u qw = mq[r], kw = mk[r];
                q[r][0] = bflo(qw.x); q[r][1] = bfhi(qw.x); q[r][2] = bflo(qw.y); q[r][3] = bfhi(qw.y); k[r][0] = bflo(kw.x); k[r][1] = bfhi(kw.x); k[r][2] = bflo(kw.y); k[r][3] = bfhi(kw.y);
                sq2[r] = (q[r][0] * q[r][0] + q[r][1] * q[r][1]) + (q[r][2] * q[r][2] + q[r][3] * q[r][3]); sk2[r] = (k[r][0] * k[r][0] + k[r][1] * k[r][1]) + (k[r][2] * k[r][2] + k[r][3] * k[r][3]); }
#pragma unroll
            for (int r = 0; r < 4; ++r) { sq2[r] = wave_sum(sq2[r]); sk2[r] = wave_sum(sk2[r]); }
            const f32x4 gn = *(const f32x4*)(INP(25) + L * 256 + c);
#pragma unroll
            for (int r = 0; r < 4; ++r) { const size_t row = row0 + r; const int t = t0 + r;
                const float rq = rsq_f(sq2[r] * (1.0f / 256.0f) + EPS), rk = rsq_f(sk2[r] * (1.0f / 256.0f) + EPS);
                v2u w; w.x = pk2(q[r][0] * rq, q[r][1] * rq); w.y = pk2(q[r][2] * rq, q[r][3] * rq); *(v2u*)(CQB + row * 256 + c) = w;
                f32x4 ck;
#pragma unroll
                for (int j = 0; j < 4; ++j) ck[j] = k[r][j] * rk * gn[j];
                float* o = F.out + (smp ? O_SCKV + (((size_t)L * 32 + sq) * 4 + t) * 256 : O_PCKV + (((size_t)L * 8 + sq) * 2048 + t) * 256) + c;
                *(f32x4*)o = ck; w.x = pk2(ck[0], ck[1]); w.y = pk2(ck[2], ck[3]); *(v2u*)(CKVB + row * 256 + c) = w; }
            { const int r = lane >> 4, kk = lane & 15; const size_t row = row0 + r; const int t = t0 + r;
              const float x1 = rx1, x2 = rx2, cs = rcs, sn = rsn;
              const float o1 = x1 * cs - x2 * sn, o2 = x2 * cs + x1 * sn;
              KRB[row * 32 + kk] = o1; KRB[row * 32 + 16 + kk] = o2;
              float* ok = F.out + (smp ? O_SKR + (((size_t)L * 32 + sq) * 4 + t) * 32 : O_PKR + (((size_t)L * 8 + sq) * 2048 + t) * 32);
              ok[kk] = o1; ok[16 + kk] = o2; }
        }
        if (mask & 64) {
            const int c = 8 * lane; float q[4][8], ss[4]; const float* gn = INP(32) + L * 128 + (c & 127);
#pragma unroll
            for (int r = 0; r < 4; ++r) { unpack8(mm[r], q[r]); ss[r] = 0.f;
#pragma unroll
                for (int j = 0; j < 8; ++j) ss[r] += q[r][j] * q[r][j]; }
#pragma unroll
            for (int r = 0; r < 4; ++r) ss[r] = sum16(ss[r]);
#pragma unroll
            for (int r = 0; r < 4; ++r) { const float rs = (rsq_f(ss[r] * (1.0f / 128.0f) + EPS)) * (0.08838834764831845f * LOG2E);
#pragma unroll
                for (int j = 0; j < 8; ++j) q[r][j] *= rs * gn[j];
                *(v4u*)(QMB + (size_t)(row0 + r) * 512 + c) = pack8(q[r]); }
        }
    }
}
#undef PREP_STAGE3

__device__ __forceinline__ void mla_post_rows(Frame& F, int L, int row0, bool smp, LAS bf16* Vl, int trow) {
    const bf16* QRAW = wsp<bf16>(F, WS_QRAW); const bf16* KVRAW = wsp<bf16>(F, WS_KVRAW); const float* KRB = wsp<float>(F, WS_KRB); const float* rope = wsp<float>(F, WS_ROPE);
    bf16* QF = wsp<bf16>(F, WS_QF); bf16* QSG = wsp<bf16>(F, WS_QSG); bf16* KF = wsp<bf16>(F, WS_KF); bf16* KFS = wsp<bf16>(F, WS_KFS);
    const float* qn = INP(27) + L * 96; const float* kn = INP(28) + L * 96;
    const float qscale = 0.10206207261596575f * LOG2E;
    const int lane = F.lane, r = lane >> 4, h = (lane >> 1) & 7, hf = lane & 1;
    const int row = row0 + r; const int t = smp ? (row - MP) & 3 : row & 2047; const int pp = smp ? 2048 + t : t;
    const bf16* qp = QRAW + (size_t)row * 1024 + h * 96;
    float q[6][8];
#pragma unroll
    for (int j = 0; j < 4; ++j) unpack8(*(const v4u*)(qp + 8 * (4 * hf + j)), q[j]);
    unpack8(*(const v4u*)(qp + 8 * (8 + hf)), q[4]); unpack8(*(const v4u*)(qp + 8 * (10 + hf)), q[5]);
    float ss = 0.f;
#pragma unroll
    for (int j = 0; j < 6; ++j)
#pragma unroll
        for (int e = 0; e < 8; ++e) ss += q[j][e] * q[j][e];
    ss += dppf<0xB1>(ss);
    const float rq = (rsq_f(ss * (1.0f / 96.0f) + EPS)) * qscale;
#pragma unroll
    for (int e = 0; e < 8; ++e) { const float cs = rope[pp * 32 + 8 * hf + e], sn = rope[pp * 32 + 16 + 8 * hf + e]; const float x1 = q[4][e], x2 = q[5][e]; q[4][e] = x1 * cs - x2 * sn; q[5][e] = x2 * cs + x1 * sn; }
    bf16* qo = QF + (size_t)row * 768 + h * 96; bf16* qs = QSG + (size_t)(smp ? row - MP : 0) * 768 + h * 96;
#pragma unroll
    for (int j = 0; j < 6; ++j) { const int ch = j < 4 ? 4 * hf + j : (j == 4 ? 8 + hf : 10 + hf);
#pragma unroll
        for (int e = 0; e < 8; ++e) q[j][e] *= rq * qn[8 * ch + e];
        *(v4u*)(qo + 8 * ch) = pack8(q[j]);
        if (smp) {
#pragma unroll
            for (int e = 0; e < 8; ++e) q[j][e] *= kn[8 * ch + e];
            *(v4u*)(qs + 8 * ch) = pack8(q[j]); } }
    const bf16* kp = KVRAW + (size_t)row * 1024 + h * 128; const float* krp = KRB + (size_t)row * 32 + 16 * hf;
    float k[6][8];
#pragma unroll
    for (int j = 0; j < 4; ++j) unpack8(*(const v4u*)(kp + 8 * (4 * hf + j)), k[j]);
#pragma unroll
    for (int j = 0; j < 2; ++j) { const f32x4 ra = *(const f32x4*)(krp + 8 * j), rb = *(const f32x4*)(krp + 8 * j + 4);
#pragma unroll
        for (int e = 0; e < 4; ++e) { k[4 + j][e] = ra[e]; k[4 + j][4 + e] = rb[e]; } }
    float sk = 0.f;
#pragma unroll
    for (int j = 0; j < 6; ++j)
#pragma unroll
        for (int e = 0; e < 8; ++e) sk += k[j][e] * k[j][e];
    sk += dppf<0xB1>(sk);
    const float rk = rsq_f(sk * (1.0f / 96.0f) + EPS);
    bf16* ko = smp ? KFS + (size_t)(row - MP) * 768 + h * 96 : KF + ((size_t)((row >> 11) * 8 + h) * 2048 + t) * 96;
#pragma unroll
    for (int j = 0; j < 6; ++j) { const int c0 = j < 4 ? 8 * (4 * hf + j) : 64 + 16 * hf + 8 * (j - 4);
#pragma unroll
        for (int e = 0; e < 8; ++e) k[j][e] *= rk * kn[c0 + e];
        *(v4u*)(ko + c0) = pack8(k[j]); }
    if (!smp) {
#pragma unroll
        for (int j = 0; j < 4; ++j) *(LAS v4u*)(Vl + (trow + r) * 520 + h * 64 + 8 * (4 * hf + j)) = *(const v4u*)(kp + 64 + 8 * (4 * hf + j)); }
}
__device__ __forceinline__ void mla_post(Frame& F, int L) {
    LAS bf16* Vl = (LAS bf16*)F.lds;
    bf16* VT = wsp<bf16>(F, WS_VT);
    for (int u = F.bid; u < 256; u += F.G) {
        const int row0 = u * 64;
        __syncthreads();
#pragma unroll 1
        for (int it = 0; it < 2; ++it) mla_post_rows(F, L, row0 + 32 * it + 4 * F.wave, false, Vl, 32 * it + 4 * F.wave);
        __syncthreads();
        {
            const int col = F.tid, b = row0 >> 11, t0 = row0 & 2047; bf16* vo = VT + ((size_t)((b * 8 + (col >> 6)) * 64 + (col & 63))) * 2048 + t0;
#pragma unroll
            for (int j = 0; j < 8; ++j) { v4u w; unsigned short e[8];
#pragma unroll
                for (int x = 0; x < 8; ++x) e[x] = Vl[(8 * j + x) * 520 + col];
                w.x = e[0] | ((unsigned)e[1] << 16); w.y = e[2] | ((unsigned)e[3] << 16); w.z = e[4] | ((unsigned)e[5] << 16); w.w = e[6] | ((unsigned)e[7] << 16);
                *(v4u*)(vo + 8 * j) = w; }
        }
    }
    for (int gidx = F.bid * NWAVES + F.wave; gidx < 32; gidx += F.G * NWAVES) mla_post_rows(F, L, MP + 4 * gidx, true, Vl, 0);
}

template <int DQK, int DV> struct AttnCfg { static constexpr int KCH = 64 * (DQK / 8), NKR = (KCH + 511) / 512, NVR = (DV * 8) / 512, NS = DQK / 32; };
template <int DQK, int DV, bool CAUSAL>
__device__ __forceinline__ void attn_unit(Frame& F, const bf16* Q, int qpitch, int nq, int q0, const bf16* K, int kpitch, const bf16* Vt, int vtpitch, int nkeys, bf16* O, int opitch,
                                          v4u (&kreg)[AttnCfg<DQK, DV>::NKR], v4u (&vreg)[AttnCfg<DQK, DV>::NVR], bf16x8 (&bq)[AttnCfg<DQK, DV>::NS], bool prefetched,
                                          const bf16* Qn, int nqn, const bf16* Kn, const bf16* Vtn, bool has_next) {
    constexpr int KP = DQK + 8, VP = 64 + 8, NS = DQK / 32, ND = DV / 16;
    LAS bf16* Ks = (LAS bf16*)F.lds; LAS bf16* Vts = (LAS bf16*)(F.lds + 64 * KP * 2);
    const int lane = F.lane, w = F.wave, lq = lane & 15, g = lane >> 4, qrow = 16 * w + lq;
    if (!prefetched) {
#pragma unroll
        for (int s = 0; s < NS; ++s) { if (qrow < nq) bq[s] = *(const bf16x8*)(Q + (size_t)qrow * qpitch + 32 * s + 8 * g); else bq[s] = (bf16x8){0, 0, 0, 0, 0, 0, 0, 0}; }
    }
    bf16x8 bqn[NS];
    f32x4 o[ND];
#pragma unroll
    for (int d = 0; d < ND; ++d) o[d] = (f32x4){0.f, 0.f, 0.f, 0.f};
    float m_run = -1e30f, l_run = 0.f;
    const int ntiles = CAUSAL ? (q0 + nq + 63) / 64 : nkeys / 64;
    const int mylast = CAUSAL ? (q0 + 16 * w + 15) / 64 : ntiles - 1;
    constexpr int KCH = AttnCfg<DQK, DV>::KCH, NKR = AttnCfg<DQK, DV>::NKR, NVR = AttnCfg<DQK, DV>::NVR;
#define ATT_FETCH(K_, Vt_, kt_) do { const int k0_ = (kt_) * 64; \
        _Pragma("unroll") for (int i_ = 0; i_ < NKR; ++i_) { const int idx = F.tid + 512 * i_; if (idx < KCH) kreg[i_] = *(const v4u*)((K_) + (size_t)(k0_ + idx / (DQK / 8)) * kpitch + (idx % (DQK / 8)) * 8); } \
        _Pragma("unroll") for (int i_ = 0; i_ < NVR; ++i_) { const int idx = F.tid + 512 * i_; vreg[i_] = *(const v4u*)((Vt_) + (size_t)(idx >> 3) * vtpitch + k0_ + (idx & 7) * 8); } } while (0)
    if (!prefetched) ATT_FETCH(K, Vt, 0);
    for (int kt = 0; kt < ntiles; ++kt) {
        const int k0 = kt * 64;
        __syncthreads();
#pragma unroll
        for (int i_ = 0; i_ < NKR; ++i_) { const int idx = F.tid + 512 * i_; if (idx < KCH) *(LAS v4u*)(Ks + (idx / (DQK / 8)) * KP + (idx % (DQK / 8)) * 8) = kreg[i_]; }
#pragma unroll
        for (int i_ = 0; i_ < NVR; ++i_) { const int idx = F.tid + 512 * i_; *(LAS v4u*)(Vts + (idx >> 3) * VP + (idx & 7) * 8) = vreg[i_]; }
        __syncthreads();
        if (kt + 1 < ntiles) ATT_FETCH(K, Vt, kt + 1);
        else if (has_next) { ATT_FETCH(Kn, Vtn, 0);
#pragma unroll
            for (int s = 0; s < NS; ++s) { if (qrow < nqn) bqn[s] = *(const bf16x8*)(Qn + (size_t)qrow * qpitch + 32 * s + 8 * g); else bqn[s] = (bf16x8){0, 0, 0, 0, 0, 0, 0, 0}; } }
        if (kt <= mylast) {
            f32x4 s[4];
            {   bf16x8 ka[4][NS];
#pragma unroll
                for (int kk = 0; kk < 4; ++kk)
#pragma unroll
                    for (int ss = 0; ss < NS; ++ss) ka[kk][ss] = *(const LAS bf16x8*)(Ks + (16 * kk + lq) * KP + 32 * ss + 8 * g);
                __builtin_amdgcn_sched_barrier(0);
#pragma unroll
                for (int kk = 0; kk < 4; ++kk) s[kk] = (f32x4){0.f, 0.f, 0.f, 0.f};
#pragma unroll
                for (int ss = 0; ss < NS; ++ss)
#pragma unroll
                    for (int kk = 0; kk < 4; ++kk) s[kk] = __builtin_amdgcn_mfma_f32_16x16x32_bf16(ka[kk][ss], bq[ss], s[kk], 0, 0, 0);
            }
            if (CAUSAL && k0 + 63 > q0 + 16 * w) {
#pragma unroll
                for (int kk = 0; kk < 4; ++kk)
#pragma unroll
                    for (int r = 0; r < 4; ++r) if (k0 + 16 * kk + 4 * g + r > q0 + qrow) s[kk][r] = -1e30f;
            }
            float mx = -1e30f;
#pragma unroll
            for (int kk = 0; kk < 4; ++kk) mx = fmaxf(fmaxf(fmaxf(s[kk][0], s[kk][1]), fmaxf(s[kk][2], s[kk][3])), mx);
            mx = xrow_max(mx);
            const float m_new = fmaxf(m_run, mx), alpha = fexp2(m_run - m_new); m_run = m_new;
            float ls = 0.f;
#pragma unroll
            for (int kk = 0; kk < 4; ++kk)
#pragma unroll
                for (int r = 0; r < 4; ++r) { s[kk][r] = fexp2(s[kk][r] - m_new); ls += s[kk][r]; }
            l_run = l_run * alpha + ls;
#pragma unroll
            for (int d = 0; d < ND; ++d) o[d] *= alpha;
#pragma unroll
            for (int u = 0; u < 2; ++u) {
                v4u pw; pw.x = pk2(s[2 * u][0], s[2 * u][1]); pw.y = pk2(s[2 * u][2], s[2 * u][3]); pw.z = pk2(s[2 * u + 1][0], s[2 * u + 1][1]); pw.w = pk2(s[2 * u + 1][2], s[2 * u + 1][3]);
                const bf16x8 bp = __builtin_bit_cast(bf16x8, pw);
                bf16x8 va[ND];
#pragma unroll
                for (int d = 0; d < ND; ++d) {
                    const v2u lo = *(const LAS v2u*)(Vts + (16 * d + lq) * VP + 32 * u + 4 * g), hi = *(const LAS v2u*)(Vts + (16 * d + lq) * VP + 32 * u + 16 + 4 * g);
                    v4u aw; aw.x = lo.x; aw.y = lo.y; aw.z = hi.x; aw.w = hi.y; va[d] = __builtin_bit_cast(bf16x8, aw); }
                __builtin_amdgcn_sched_barrier(0);
#pragma unroll
                for (int d = 0; d < ND; ++d) o[d] = __builtin_amdgcn_mfma_f32_16x16x32_bf16(va[d], bp, o[d], 0, 0, 0);
            }
        }
    }
#undef ATT_FETCH
    float lt = xrow_sum(l_run);
    const float inv = 1.0f / lt;
    if (qrow < nq) {
#pragma unroll
        for (int d = 0; d < ND; ++d) { v2u wv; wv.x = pk2(o[d][0] * inv, o[d][1] * inv); wv.y = pk2(o[d][2] * inv, o[d][3] * inv); *(v2u*)(O + (size_t)qrow * opitch + 16 * d + 4 * g) = wv; }
    }
    if (has_next) {
#pragma unroll
        for (int s = 0; s < NS; ++s) bq[s] = bqn[s]; }
}
__device__ __forceinline__ void mla_prompt_attn(Frame& F) {
    const bf16* QF = wsp<bf16>(F, WS_QF); const bf16* KF = wsp<bf16>(F, WS_KF); const bf16* VT = wsp<bf16>(F, WS_VT); bf16* OMLA = wsp<bf16>(F, WS_OMLA);
    const bool skip32 = F.G > 64; const int G2 = skip32 ? F.G - 32 : F.G, b2 = skip32 ? F.bid - 32 : F.bid;
    if (b2 < 0) return;
    v4u kreg[AttnCfg<96, 64>::NKR], vreg[AttnCfg<96, 64>::NVR]; bf16x8 bq[AttnCfg<96, 64>::NS]; bool pf = false;
    for (int rr = 0; ; ++rr) {
        const int u = rr * G2 + ((rr & 1) ? G2 - 1 - b2 : b2); if (u >= 1024) break;
        const int qb = 15 - (u >> 6), bh = u & 63;
        const int b = bh >> 3, h = bh & 7;
        const int un = (rr + 1) * G2 + (((rr + 1) & 1) ? G2 - 1 - b2 : b2); const bool hn = un < 1024;
        const int qbn = 15 - ((hn ? un : u) >> 6), bhn = (hn ? un : u) & 63, bn = bhn >> 3, hnn = bhn & 7;
        attn_unit<96, 64, true>(F, QF + ((size_t)(b * 2048 + 128 * qb) * 8 + h) * 96, 768, 128, 128 * qb, KF + (size_t)(bh * 2048) * 96, 96, VT + (size_t)(bh * 64) * 2048, 2048, 2048,
                                OMLA + (size_t)(b * 2048 + 128 * qb) * 512 + h * 64, 512, kreg, vreg, bq, pf,
                                QF + ((size_t)(bn * 2048 + 128 * qbn) * 8 + hnn) * 96, 128, KF + (size_t)(bhn * 2048) * 96, VT + (size_t)(bhn * 64) * 2048, hn);
        pf = hn;
    }
}
__device__ __forceinline__ void mem_attn(Frame& F, int L) {
    const bf16* QMB = wsp<bf16>(F, WS_QMB); const bf16* MK = wsp<bf16>(F, WS_MK); const bf16* MVT = wsp<bf16>(F, WS_MVT); bf16* OMEM = wsp<bf16>(F, WS_OMEM);
    const bool skip32 = F.G > 64;
    const int G2 = skip32 ? F.G - 32 : F.G, b2 = skip32 ? F.bid - 32 : F.bid;
    if (b2 < 0) return;
    v4u kreg[AttnCfg<128, 128>::NKR], vreg[AttnCfg<128, 128>::NVR]; bf16x8 bq[AttnCfg<128, 128>::NS]; bool pf = false;
#define MEM_UNIT(u_, sq_, h_, row0_, nq_) do { if ((u_) < 512) { sq_ = (u_) >> 6; h_ = ((u_) >> 4) & 3; row0_ = sq_ * 2048 + ((u_) & 15) * 128; nq_ = 128; } \
        else { const int v_ = (u_) - 512; sq_ = 8 + (v_ >> 2); h_ = v_ & 3; row0_ = MP + (v_ >> 2) * 4; nq_ = 4; } } while (0)
    for (int u = b2; u < 512 + 128; u += G2) {
        int sq, h, row0, nq; MEM_UNIT(u, sq, h, row0, nq);
        const bool hn = u + G2 < 512 + 128; const int un = hn ? u + G2 : u;
        int sqn, hnn, row0n, nqn; MEM_UNIT(un, sqn, hnn, row0n, nqn);
        const size_t kvo = (((size_t)L * NSEQ + sq) * 4 + h) * 256 * 128, kvon = (((size_t)L * NSEQ + sqn) * 4 + hnn) * 256 * 128;
        attn_unit<128, 128, false>(F, QMB + (size_t)row0 * 512 + h * 128, 512, nq, 0, MK + kvo, 128, MVT + kvo, 256, 256, OMEM + (size_t)row0 * 512 + h * 128, 512, kreg, vreg, bq, pf,
                                   QMB + (size_t)row0n * 512 + hnn * 128, nqn, MK + kvon, MVT + kvon, hn);
        pf = hn;
    }
#undef MEM_UNIT
}
typedef short v4i16_t __attribute__((ext_vector_type(4)));
__device__ __forceinline__ void wuk_swizzle(Frame& F, int L) {
    const bf16* W = wl(F, L, WL_KVB); bf16* dst = wsp<bf16>(F, WS_WUKS) + (size_t)L * 131072;
    for (int t = F.bid * (NWAVES * 64) + F.tid; t < 16384; t += F.G * (NWAVES * 64)) {
        const int ln = t & 63, dt = (t >> 6) & 3, ks = (t >> 8) & 7, h = t >> 11;
        *(v4u*)(dst + (size_t)t * 8) = *(const v4u*)(W + (size_t)(h * 128 + 16 * dt + (ln & 15)) * 256 + 32 * ks + 8 * (ln >> 4));
    }
}
__device__ __forceinline__ void mla_sample_attn(Frame& F, int L) {
    constexpr int CP = 264, KRP = 40, PP = 72, SP = 68;
    LAS float* STC = (LAS float*)F.lds;
    LAS float* STR = (LAS float*)(F.lds + 65536);
    LAS bf16* Cs = (LAS bf16*)(F.lds + 73728);
    LAS bf16* KRs = (LAS bf16*)(F.lds + 107520);
    LAS bf16* Ps = (LAS bf16*)(F.lds + 112640);
    LAS float* KRSS = (LAS float*)(F.lds + 117248);
    LAS float* ALs = (LAS float*)(F.lds + 117504);
    LAS float* Ss = (LAS float*)(F.lds + 117632);
    LAS bf16* Qs = (LAS bf16*)(F.lds + 132096);
    const int lane = F.lane, w = F.wave, lq = lane & 15, g = lane >> 4, h = w;
    const bf16* QSG = wsp<bf16>(F, WS_QSG); const bf16* Wuks = wsp<bf16>(F, WS_WUKS) + (size_t)L * 131072;
    float* PART = wsp<float>(F, WS_PART); float* ML = wsp<float>(F, WS_ML);
    const GAS float* cache_c = (const GAS float*)(F.in[5]) + (size_t)L * NPHYS * 128 * 256; const GAS float* cache_r = (const GAS float*)(F.in[6]) + (size_t)L * NPHYS * 128 * 32;
    const int nst = 8 * ((1024 - F.bid + F.G - 1) / F.G);
#define MLS_PGID(dst_, s_) do { const int* pa_ = F.page_table + (((F.bid + ((s_) >> 3) * F.G) >> 5) * 128 + ((F.bid + ((s_) >> 3) * F.G) & 31) * 4 + (((s_) >> 1) & 3)); \
        asm volatile("s_load_dword %0, %1, 0x0\n\ts_waitcnt lgkmcnt(0)" : "=s"(dst_) : "s"(pa_) : "memory"); } while (0)
#define MLS_DMA(s_, ph_) do { const GAS float* cp_ = cache_c + ((size_t)(ph_) * 128 + ((s_) & 1) * 64) * 256; const GAS float* rp_ = cache_r + ((size_t)(ph_) * 128 + ((s_) & 1) * 64) * 32; \
        _Pragma("unroll") for (int it = 0; it < 8; ++it) __builtin_amdgcn_global_load_lds((const unsigned*)(const float*)(cp_ + (size_t)(w + 8 * it) * 256 + 4 * lane), (LAS unsigned*)(STC + (w + 8 * it) * 256), 16, 0, 0); \
        __builtin_amdgcn_global_load_lds((const unsigned*)(const float*)(rp_ + (size_t)w * 256 + 4 * lane), (LAS unsigned*)(STR + w * 256), 16, 0, 0); } while (0)
#define MLS_CONVERT() do { \
        _Pragma("unroll") for (int hb = 0; hb < 2; ++hb) { f32x4 cv_[4]; \
            _Pragma("unroll") for (int it = 0; it < 4; ++it) { const int idx = F.tid + 512 * (4 * hb + it), row = idx >> 6, c4 = idx & 63; cv_[it] = *(const LAS f32x4*)(STC + row * 256 + c4 * 4); } \
            __builtin_amdgcn_sched_barrier(0); \
            _Pragma("unroll") for (int it = 0; it < 4; ++it) { const int idx = F.tid + 512 * (4 * hb + it), row = idx >> 6, c4 = idx & 63; const f32x4 v = cv_[it]; \
                v2u wv; wv.x = pk2(v[0], v[1]); wv.y = pk2(v[2], v[3]); *(LAS v2u*)(Cs + row * CP + c4 * 4) = wv; } \
            __builtin_amdgcn_sched_barrier(0); } \
        { const int row = F.tid >> 3, c4 = F.tid & 7; const f32x4 v = *(const LAS f32x4*)(STR + row * 32 + c4 * 4); \
            v2u wv; wv.x = pk2(v[0], v[1]); wv.y = pk2(v[2], v[3]); *(LAS v2u*)(KRs + row * KRP + c4 * 4) = wv; \
            float s8 = (bflo(wv.x) * bflo(wv.x) + bfhi(wv.x) * bfhi(wv.x)) + (bflo(wv.y) * bflo(wv.y) + bfhi(wv.y) * bfhi(wv.y)); \
            s8 = row8_sum(s8); \
            if (c4 == 0) KRSS[row] = s8; } } while (0)
#define MLS_QSTAGE(ui_) do { if (F.tid < 384) { const int u_ = F.bid + (ui_) * F.G, db_ = u_ >> 5, r_ = F.tid / 12, c_ = F.tid % 12, q_ = r_ >> 3, h_ = r_ & 7; \
        *(LAS v4u*)(Qs + ((ui_) & 1) * 3072 + (h_ * 4 + q_) * 96 + 8 * c_) = *(const v4u*)(QSG + ((size_t)(db_ * 4 + q_) * 8 + h_) * 96 + 8 * c_); } } while (0)
    __syncthreads();
    bf16x8 wr[8][4];
#pragma unroll
    for (int ks = 0; ks < 8; ++ks)
#pragma unroll
        for (int dt = 0; dt < 4; ++dt) wr[ks][dt] = *(const bf16x8*)(Wuks + ((size_t)(((h * 8 + ks) * 4 + dt) * 64 + lane)) * 8);
    MLS_QSTAGE(0);
    { int ph0; MLS_PGID(ph0, 0); MLS_DMA(0, ph0); }
    asm volatile("s_waitcnt vmcnt(0)" ::: "memory");
    __syncthreads();
    MLS_CONVERT();
    __syncthreads();
    { const int s1 = 1 < nst ? 1 : 0; int ph1; MLS_PGID(ph1, s1); MLS_DMA(s1, ph1); }
    f32x4 pc[2][2]; float m_run = -1e30f, l_run = 0.f;
#pragma unroll
    for (int a_ = 0; a_ < 2; ++a_)
#pragma unroll
        for (int b_ = 0; b_ < 2; ++b_) pc[a_][b_] = (f32x4){0.f, 0.f, 0.f, 0.f};
#pragma unroll 1
    for (int i = 0; i < nst; ++i) {
        const int ui = i >> 3, u = F.bid + ui * F.G, j = i & 7, db = u >> 5, grp = u & 31;
        const int sn = i + 2 < nst ? i + 2 : nst - 1;
        int ph; MLS_PGID(ph, sn);
        if (j == 0) {
#pragma unroll
            for (int a_ = 0; a_ < 2; ++a_)
#pragma unroll
                for (int b_ = 0; b_ < 2; ++b_) pc[a_][b_] = (f32x4){0.f, 0.f, 0.f, 0.f};
            m_run = -1e30f; l_run = 0.f;
        }
        bf16x8 b[4];
#pragma unroll
        for (int ks = 0; ks < 2; ++ks) b[ks] = *(const LAS bf16x8*)(Cs + lq * CP + 8 * g + 32 * ks);
#pragma unroll 1
        for (int kk = 0; kk < 4; ++kk) {
            f32x4 acc[4];
#pragma unroll
            for (int dt = 0; dt < 4; ++dt) acc[dt] = (f32x4){0.f, 0.f, 0.f, 0.f};
            const LAS bf16* cb = Cs + (16 * kk + lq) * CP + 8 * g;
            const LAS bf16* cn = Cs + (16 * ((kk + 1) & 3) + lq) * CP + 8 * g;
#pragma unroll
            for (int ks = 2; ks < 4; ++ks) b[ks] = *(const LAS bf16x8*)(cb + 32 * ks);
            __builtin_amdgcn_sched_barrier(0);
#pragma unroll
            for (int ks = 0; ks < 8; ++ks) {
#pragma unroll
                for (int dt = 0; dt < 4; ++dt) acc[dt] = __builtin_amdgcn_mfma_f32_16x16x32_bf16(wr[ks][dt], b[ks & 3], acc[dt], 0, 0, 0);
                if (ks < 4) b[ks & 3] = *(const LAS bf16x8*)(cb + 32 * (ks + 4));
                else if (ks < 6) b[ks & 3] = *(const LAS bf16x8*)(cn + 32 * (ks - 4));
                __builtin_amdgcn_sched_barrier(0);
            }
            bf16x8 aq[2], aqr;
            {
            const LAS bf16* qp = Qs + (ui & 1) * 3072 + (h * 4 + (lq & 3)) * 96; const bool ok = lq < 4;
#pragma unroll
            for (int s = 0; s < 2; ++s) { v2u lo = *(const LAS v2u*)(qp + 32 * s + 4 * g), hi = *(const LAS v2u*)(qp + 32 * s + 16 + 4 * g); v4u t; t.x = ok ? lo.x : 0u; t.y = ok ? lo.y : 0u; t.z = ok ? hi.x : 0u; t.w = ok ? hi.y : 0u; aq[s] = __builtin_bit_cast(bf16x8, t); }
            v4u t = *(const LAS v4u*)(qp + 64 + 8 * g); if (!ok) { t.x = 0u; t.y = 0u; t.z = 0u; t.w = 0u; } aqr = __builtin_bit_cast(bf16x8, t);
            }
            {
                float ss = 0.f;
#pragma unroll
                for (int dt = 0; dt < 4; ++dt) ss += (acc[dt][0] * acc[dt][0] + acc[dt][1] * acc[dt][1]) + (acc[dt][2] * acc[dt][2] + acc[dt][3] * acc[dt][3]);
                ss = xrow_sum(ss);
                const float rstd = rsq_f((ss + KRSS[16 * kk + lq]) * (1.0f / 96.0f) + EPS);
                f32x4 sa = (f32x4){0.f, 0.f, 0.f, 0.f};
#pragma unroll
                for (int s2 = 0; s2 < 2; ++s2) { v4u bw; bw.x = pk2(acc[2 * s2][0], acc[2 * s2][1]); bw.y = pk2(acc[2 * s2][2], acc[2 * s2][3]); bw.z = pk2(acc[2 * s2 + 1][0], acc[2 * s2 + 1][1]); bw.w = pk2(acc[2 * s2 + 1][2], acc[2 * s2 + 1][3]);
                    sa = __builtin_amdgcn_mfma_f32_16x16x32_bf16(aq[s2], __builtin_bit_cast(bf16x8, bw), sa, 0, 0, 0); }
                const bf16x8 bkr = *(const LAS bf16x8*)(KRs + (16 * kk + lq) * KRP + 8 * g);
                sa = __builtin_amdgcn_mfma_f32_16x16x32_bf16(aqr, bkr, sa, 0, 0, 0);
                if (g == 0) {
#pragma unroll
                    for (int r = 0; r < 4; ++r) Ss[(h * 4 + r) * SP + 16 * kk + lq] = sa[r] * rstd; }
            }
        }
        LDS_WAIT(); asm volatile("" ::: "memory");
        {
            float sc[4];
#pragma unroll
            for (int kt = 0; kt < 4; ++kt) sc[kt] = Ss[(h * 4 + g) * SP + 16 * kt + lq];
            float mx = fmaxf(fmaxf(sc[0], sc[1]), fmaxf(sc[2], sc[3]));
            mx = max16(mx);
            const float m_new = fmaxf(m_run, mx), alpha = fexp2(m_run - m_new); m_run = m_new;
            float ls = 0.f;
#pragma unroll
            for (int kt = 0; kt < 4; ++kt) { sc[kt] = fexp2(sc[kt] - m_new); ls += sc[kt]; Ps[(h * 4 + g) * PP + 16 * kt + lq] = (bf16)f2bf(sc[kt]); }
            l_run = l_run * alpha + ls;
            if (lq == 0) ALs[h * 4 + g] = alpha;
        }
        LDS_WAIT(); asm volatile("" ::: "memory"); __builtin_amdgcn_s_barrier(); asm volatile("" ::: "memory");
#pragma unroll
        for (int rt = 0; rt < 2; ++rt)
#pragma unroll
            for (int r = 0; r < 4; ++r) { const float al = ALs[16 * rt + 4 * g + r]; pc[rt][0][r] *= al; pc[rt][1][r] *= al; }
#pragma unroll
        for (int ks = 0; ks < 2; ++ks) {
            bf16x8 pa[2];
#pragma unroll
            for (int rt = 0; rt < 2; ++rt) pa[rt] = *(const LAS bf16x8*)(Ps + (16 * rt + lq) * PP + 32 * ks + 8 * g);
#pragma unroll
            for (int ct = 0; ct < 2; ++ct) {
                const int c = 2 * w + ct, qq = lq >> 2, pp = lq & 3;
                const v4i16_t t0 = __builtin_amdgcn_ds_read_tr16_b64_v4i16((LAS v4i16_t*)(Cs + (32 * ks + 8 * g + qq) * CP + 16 * c + 4 * pp));
                const v4i16_t t1 = __builtin_amdgcn_ds_read_tr16_b64_v4i16((LAS v4i16_t*)(Cs + (32 * ks + 8 * g + 4 + qq) * CP + 16 * c + 4 * pp));
                const bf16x8 bc = (bf16x8){t0[0], t0[1], t0[2], t0[3], t1[0], t1[1], t1[2], t1[3]};
#pragma unroll
                for (int rt = 0; rt < 2; ++rt) pc[rt][ct] = __builtin_amdgcn_mfma_f32_16x16x32_bf16(pa[rt], bc, pc[rt][ct], 0, 0, 0);
            }
        }
        if (j == 7) {
#pragma unroll
            for (int rt = 0; rt < 2; ++rt)
#pragma unroll
                for (int ct = 0; ct < 2; ++ct)
#pragma unroll
                    for (int r = 0; r < 4; ++r) PART[((size_t)(db * 32 + grp) * 32 + 16 * rt + 4 * g + r) * 256 + 16 * (2 * w + ct) + lq] = pc[rt][ct][r];
            { float lt = sum16(l_run);
                if (lq == 0) { ML[((size_t)(db * 32 + grp) * 32 + h * 4 + g) * 2] = m_run; ML[((size_t)(db * 32 + grp) * 32 + h * 4 + g) * 2 + 1] = lt; } }
        }
        asm volatile("s_waitcnt vmcnt(0)" ::: "memory");
        __syncthreads();
        MLS_CONVERT();
        if (j == 7 && i + 1 < nst) MLS_QSTAGE(ui + 1);
        __syncthreads();
        MLS_DMA(sn, ph);
    }
    asm volatile("s_waitcnt vmcnt(0)" ::: "memory");
    __syncthreads();
#undef MLS_PGID
#undef MLS_DMA
#undef MLS_CONVERT
#undef MLS_QSTAGE
}
__device__ __forceinline__ void mla_sample_combine(Frame& F, int L) {
    const int gw = F.bid * NWAVES + F.wave, NGW = F.G * NWAVES, lane = F.lane;
    LAS float* pcs = (LAS float*)(F.lds + F.wave * 1024);
    const float* PART = wsp<float>(F, WS_PART); const float* ML = wsp<float>(F, WS_ML);
    const bf16* QF = wsp<bf16>(F, WS_QF); const bf16* KFS = wsp<bf16>(F, WS_KFS); bf16* OMLA = wsp<bf16>(F, WS_OMLA);
    const float* wkv = INP(26) + (size_t)L * 256 * 1024;
    for (int it = gw; it < 1024; it += NGW) {
        const int db = it >> 5, hq = it & 31, h = hq >> 2, q = hq & 3;
        float mg = -1e30f, lg = 0.f;
        if (lane < 32) { mg = ML[((size_t)(db * 32 + lane) * 32 + hq) * 2]; lg = ML[((size_t)(db * 32 + lane) * 32 + hq) * 2 + 1]; }
        float M = mg;
        M = xrow_max(max16(M));
        float sn[4];
        const bf16* qp = QF + ((size_t)(MP + db * 4 + q) * 8 + h) * 96;
#pragma unroll
        for (int j = 0; j < 4; ++j) { const bf16* kp = KFS + ((size_t)(db * 4 + j) * 8 + h) * 96; float s = bf2f(qp[lane]) * bf2f(kp[lane]); if (lane < 32) s += bf2f(qp[64 + lane]) * bf2f(kp[64 + lane]);
            sn[j] = wave_sum(s); if (j <= q) M = fmaxf(M, sn[j]); }
        const float wg = fexp2(mg - M);
        float lt = wave_sum(wg * lg);
        f32x4 pc = (f32x4){0.f, 0.f, 0.f, 0.f};
        for (int grp = 0; grp < 32; ++grp) { const float wgt = __shfl(wg, grp); pc += *(const f32x4*)(PART + ((size_t)(db * 32 + grp) * 32 + hq) * 256 + 4 * lane) * wgt; }
#pragma unroll
        for (int j = 0; j < 4; ++j) if (j <= q) { const float pj = fexp2(sn[j] - M); lt += pj; pc += *(const f32x4*)(F.out + O_SCKV + (((size_t)L * 32 + db) * 4 + j) * 256 + 4 * lane) * pj; }
        const float inv = 1.0f / lt;
        *(LAS f32x4*)(pcs + 4 * lane) = pc * inv;
        LDS_WAIT(); asm volatile("" ::: "memory");
        float o = 0.f;
#pragma unroll 8
        for (int r = 0; r < 256; ++r) o += pcs[r] * wkv[(size_t)r * 1024 + h * 128 + 64 + lane];
        OMLA[(size_t)(MP + db * 4 + q) * 512 + h * 64 + lane] = (bf16)f2bf(o);
        LDS_WAIT(); asm volatile("" ::: "memory");
    }
}

__device__ __forceinline__ void dn_seq(Frame& F, int L) {
    LAS bf16* Kq = (LAS bf16*)F.lds; LAS bf16* Qq = (LAS bf16*)(F.lds + 4096); LAS float* Vv = (LAS float*)(F.lds + 8192);
    LAS float* Gg = (LAS float*)(F.lds + 9216); LAS float* Bb = (LAS float*)(F.lds + 9280); LAS float* KQ = (LAS float*)(F.lds + 9344);
    const bf16* QKVN = wsp<bf16>(F, WS_QKVN); const float* GB = wsp<float>(F, WS_GB); float* ORAW = wsp<float>(F, WS_ORAW);
    const int lane = F.lane, e = 2 * F.wave + (lane >> 5), dg = lane & 31;
    const int GS = F.G >= 32 ? (F.G & ~31) : F.G;
    for (int base = F.bid; base < 1024 && F.bid < GS; base += 4 * GS) {
        const int h = (base >> 3) & 3, sl = base & 7, col = h * 128 + sl * 16 + e;
        float S[4][4];
#pragma unroll
        for (int j = 0; j < 4; ++j) { const int v = base + j * GS; const int sq = (v < 1024 ? v : base) >> 5;
#pragma unroll
            for (int i = 0; i < 4; ++i) S[j][i] = INP(2)[((((size_t)L * 32 + sq) * 4 + h) * 128 + 4 * dg + i) * 128 + sl * 16 + e]; }
        __syncthreads();
        {
            const int t = F.tid & 255, j = t >> 6, r = (t >> 4) & 3, c = t & 15; const int v = base + j * GS; const int sq = (v < 1024 ? v : base) >> 5; const size_t row = MP + sq * 4 + r;
            if (F.tid < 256) { const bf16* src = QKVN + row * 1536 + h * 128 + c * 8; *(LAS v4u*)(Qq + (j * 4 + r) * 128 + c * 8) = *(const v4u*)src; *(LAS v4u*)(Kq + (j * 4 + r) * 128 + c * 8) = *(const v4u*)(src + 512); }
            else Vv[(j * 4 + r) * 16 + c] = bf2f(QKVN[row * 1536 + 1024 + h * 128 + sl * 16 + c]);
            if (F.tid < 16) { const int j2 = F.tid >> 2, r2 = F.tid & 3; const int v2 = base + j2 * GS; const int sq2 = (v2 < 1024 ? v2 : base) >> 5; const size_t row2 = MP + sq2 * 4 + r2;
                Gg[F.tid] = expf(GB[row2 * 8 + h]); Bb[F.tid] = GB[row2 * 8 + 4 + h]; }
        }
        __syncthreads();
        if (F.tid < 16) { float s = 0.f;
            for (int jj = 0; jj < 16; ++jj) { float a[8], b[8]; unpack8(*(const LAS v4u*)(Kq + F.tid * 128 + 8 * jj), a); unpack8(*(const LAS v4u*)(Qq + F.tid * 128 + 8 * jj), b);
#pragma unroll
                for (int x = 0; x < 8; ++x) s += a[x] * b[x]; }
            KQ[F.tid] = s; }
        __syncthreads();
#pragma unroll
        for (int tt = 0; tt < 4; ++tt) {
#pragma unroll
            for (int j = 0; j < 4; ++j) {
                const v2u kw = *(const LAS v2u*)(Kq + (j * 4 + tt) * 128 + 4 * dg), qw = *(const LAS v2u*)(Qq + (j * 4 + tt) * 128 + 4 * dg);
                const float k0 = bflo(kw.x), k1 = bfhi(kw.x), k2 = bflo(kw.y), k3 = bfhi(kw.y), q0 = bflo(qw.x), q1 = bfhi(qw.x), q2 = bflo(qw.y), q3 = bfhi(qw.y);
                float pk = (k0 * S[j][0] + k1 * S[j][1]) + (k2 * S[j][2] + k3 * S[j][3]), pq = (q0 * S[j][0] + q1 * S[j][1]) + (q2 * S[j][2] + q3 * S[j][3]);
                pk = xsum16(sum16(pk)); pq = xsum16(sum16(pq));
                const float eg = Gg[j * 4 + tt], be = Bb[j * 4 + tt], vv = Vv[(j * 4 + tt) * 16 + e], kq = KQ[j * 4 + tt];
                const float delta = be * (vv - eg * pk);
                const float o = (eg * pq + delta * kq) * 0.08838834764831845f;
                S[j][0] = eg * S[j][0] + k0 * delta; S[j][1] = eg * S[j][1] + k1 * delta; S[j][2] = eg * S[j][2] + k2 * delta; S[j][3] = eg * S[j][3] + k3 * delta;
                const int v = base + j * GS;
                if (dg == 0 && v < 1024) ORAW[(size_t)(MP + (v >> 5) * 4 + tt) * 512 + col] = o;
            }
        }
#pragma unroll
        for (int j = 0; j < 4; ++j) { const int v = base + j * GS;
            if (v < 1024) { float* so = F.out + O_SDNS + (((size_t)L * 32 + (v >> 5)) * 4 + h) * 128 * 128;
#pragma unroll
                for (int i = 0; i < 4; ++i) so[(size_t)(4 * dg + i) * 128 + sl * 16 + e] = S[j][i]; } }
    }
}
__device__ __forceinline__ void dn_post(Frame& F, int L) {
    const int gw = F.bid * NWAVES + F.wave, NGW = F.G * NWAVES, lane = F.lane;
    const float* ORAW = wsp<float>(F, WS_ORAW); const bf16* P = wsp<bf16>(F, WS_P); bf16* ODN = wsp<bf16>(F, WS_ODN);
    const int c = 8 * lane; const float* gn = INP(19) + L * 128 + (c & 127);
    f32x4 an, bn; v4u zn;
    const bool split = NGW >= 2048; const int first = !split ? gw : (gw < 1024 ? gw : 2048 + (gw - 1024)), stride = !split ? NGW : (gw < 1024 ? 1024 : NGW - 1024), lim = !split ? MV : (gw < 1024 ? 2048 : MV);
    if (first < lim) { an = *(const f32x4*)(ORAW + (size_t)first * 512 + c); bn = *(const f32x4*)(ORAW + (size_t)first * 512 + c + 4); zn = *(const v4u*)(P + (size_t)first * NINP + PC_Z + c); }
    for (int row = first; row < lim; row += stride) {
        const f32x4 a = an, b = bn; const v4u zr = zn;
        { const int rn = row + stride < lim ? row + stride : row;
          an = *(const f32x4*)(ORAW + (size_t)rn * 512 + c); bn = *(const f32x4*)(ORAW + (size_t)rn * 512 + c + 4); zn = *(const v4u*)(P + (size_t)rn * NINP + PC_Z + c); }
        float x[8] = {a[0], a[1], a[2], a[3], b[0], b[1], b[2], b[3]}; float ss = 0.f;
#pragma unroll
        for (int j = 0; j < 8; ++j) ss += x[j] * x[j];
        ss = sum16(ss); const float rs = rsq_f(ss * (1.0f / 128.0f) + EPS);
        float z[8]; unpack8(zr, z);
#pragma unroll
        for (int j = 0; j < 8; ++j) x[j] = x[j] * rs * gn[j] * silu_f(z[j]);
        *(v4u*)(ODN + (size_t)row * 512 + c) = pack8(x);
    }
}
constexpr size_t DNC_U = 0;
constexpr size_t DNC_W = DNC_U + (size_t)1024 * 64 * 128 * 4;
constexpr size_t DNC_QG = DNC_W + (size_t)1024 * 64 * 128 * 2;
constexpr size_t DNC_KT = DNC_QG + (size_t)1024 * 64 * 128 * 2;
constexpr size_t DNC_AQK = DNC_KT + (size_t)1024 * 64 * 128 * 2;
constexpr size_t DNC_GL = DNC_AQK + (size_t)1024 * 64 * 64 * 2;
constexpr size_t DNC_SIZE = DNC_GL + 1024 * 4;
static_assert(DNC_SIZE <= WS_DNC_BYTES, "DN chunk scratch");

__device__ __forceinline__ void dn_chunk_prep(Frame& F, int L) {
    constexpr int TP = 136, AP = 68;
    LAS bf16* Ks = (LAS bf16*)F.lds; LAS bf16* Qs = (LAS bf16*)(F.lds + 17408); LAS bf16* Vs = (LAS bf16*)(F.lds + 34816);
    LAS float* ATs = (LAS float*)(F.lds + 52224); LAS float* GCs = (LAS float*)(F.lds + 69632); LAS float* EGs = (LAS float*)(F.lds + 69888); LAS float* BEs = (LAS float*)(F.lds + 70144);
    const bf16* QKVN = wsp<bf16>(F, WS_QKVN); const float* GB = wsp<float>(F, WS_GB);
    unsigned char* dnc = F.ws + WS_DNC;
    const int lane = F.lane, w = F.wave, lq = lane & 15, g = lane >> 4;
    v4u pre[6];
#define DNC_FETCH(uu_) do { const int n_ = (uu_) & 31, h_ = ((uu_) >> 5) & 3, b_ = (uu_) >> 7; const int row0_ = b_ * 2048 + n_ * 64; \
        _Pragma("unroll") for (int j_ = 0; j_ < 6; ++j_) { const int idx = F.tid + 512 * j_; const int m = idx >> 10, r = (idx >> 4) & 63, ch = idx & 15; \
            pre[j_] = *(const v4u*)(QKVN + (size_t)(row0_ + r) * 1536 + m * 512 + h_ * 128 + ch * 8); } } while (0)
    if (F.bid < 1024) DNC_FETCH(F.bid);
    for (int uu = F.bid; uu < 1024; uu += F.G) {
        const int n = uu & 31, h = (uu >> 5) & 3, b = uu >> 7; const int row0 = b * 2048 + n * 64;
        __syncthreads();
#pragma unroll
        for (int j_ = 0; j_ < 6; ++j_) { const int idx = F.tid + 512 * j_; const int m = idx >> 10, r = (idx >> 4) & 63, ch = idx & 15;
            LAS bf16* dst = (m == 0 ? Qs : (m == 1 ? Ks : Vs)); *(LAS v4u*)(dst + r * TP + ch * 8) = pre[j_]; }
        if (w == 0) { float x = GB[(size_t)(row0 + lane) * 8 + h]; const float be = GB[(size_t)(row0 + lane) * 8 + 4 + h];
#pragma unroll
            for (int o = 1; o < 64; o <<= 1) { const float t = __shfl_up(x, o); if (lane >= o) x += t; }
            GCs[lane] = x; EGs[lane] = expf(x); BEs[lane] = be; }
        __syncthreads();
        {
            const int type = w >> 2, it = w & 3; const LAS bf16* Xs = type ? Qs : Ks;
            bf16x8 a[4];
#pragma unroll
            for (int ks = 0; ks < 4; ++ks) a[ks] = *(const LAS bf16x8*)(Xs + (16 * it + lq) * TP + 32 * ks + 8 * g);
            bf16* aqk = (bf16*)(dnc + DNC_AQK) + (size_t)uu * 4096;
#pragma unroll
            for (int jt = 0; jt < 4; ++jt) {
                f32x4 acc = (f32x4){0.f, 0.f, 0.f, 0.f};
                if (jt <= it) {
#pragma unroll
                    for (int ks = 0; ks < 4; ++ks) { const bf16x8 bb = *(const LAS bf16x8*)(Ks + (16 * jt + lq) * TP + 32 * ks + 8 * g); acc = __builtin_amdgcn_mfma_f32_16x16x32_bf16(a[ks], bb, acc, 0, 0, 0); } }
                const int j = 16 * jt + lq; const float gcj = GCs[j];
#pragma unroll
                for (int r = 0; r < 4; ++r) { const int i = 16 * it + 4 * g + r; const float e = expf(GCs[i] - gcj);
                    if (type == 0) { ATs[j * AP + i] = (j < i) ? BEs[i] * e * acc[r] : 0.f; }
                    else { aqk[i * 64 + j] = (bf16)f2bf((j <= i) ? e * acc[r] * 0.08838834764831845f : 0.f); } }
            }
        }
        __syncthreads();
        if (uu + F.G < 1024) DNC_FETCH(uu + F.G);
        if (F.tid < 256) {
            const int c = F.tid; float r[64]; int vz = 0; asm volatile("" : "+v"(vz));
            const LAS float* ATv = ATs + vz; const LAS float* BEv = BEs + vz; const LAS float* EGv = EGs + vz;
            if (c < 128) {
#pragma unroll
                for (int i = 0; i < 64; ++i) r[i] = BEv[i] * bf2f(Vs[i * TP + c]); }
            else {
#pragma unroll
                for (int i = 0; i < 64; ++i) r[i] = BEv[i] * EGv[i] * bf2f(Ks[i * TP + (c - 128)]); }
            f32x4 cur[16];
#pragma unroll
            for (int q = 0; q < 16; ++q) cur[q] = *(const LAS f32x4*)(ATv + 4 * q);
#pragma unroll
            for (int j = 0; j < 63; ++j) {
                const float s = r[j];
#pragma unroll
                for (int q = (j + 1) / 4; q < 16; ++q) {
#pragma unroll
                    for (int e = 0; e < 4; ++e) if (4 * q + e > j) r[4 * q + e] -= cur[q][e] * s;
                    if (j < 62 && q >= (j + 2) / 4) cur[q] = *(const LAS f32x4*)(ATv + (j + 1) * AP + 4 * q);
                }
            }
            if (c < 128) {
                f32x4* U = (f32x4*)((float*)(dnc + DNC_U) + (size_t)uu * 8192) + (size_t)(c >> 4) * 256 + (c & 15) * 4;
#pragma unroll
                for (int rt = 0; rt < 4; ++rt)
#pragma unroll
                    for (int g4 = 0; g4 < 4; ++g4) U[g4 * 64 + rt] = (f32x4){r[16 * rt + 4 * g4], r[16 * rt + 4 * g4 + 1], r[16 * rt + 4 * g4 + 2], r[16 * rt + 4 * g4 + 3]}; }
            else { bf16* W = (bf16*)(dnc + DNC_W) + (size_t)uu * 8192;
#pragma unroll
                for (int i = 0; i < 64; ++i) W[i * 128 + (c - 128)] = (bf16)f2bf(-r[i]); }
        } else {
            const int tt = F.tid - 256;
            {
                const int i = tt >> 2, c0 = (tt & 3) * 32; const float sc = EGs[i] * 0.08838834764831845f; bf16* QG = (bf16*)(dnc + DNC_QG) + (size_t)uu * 8192;
#pragma unroll
                for (int j = 0; j < 4; ++j) { float f[8]; unpack8(*(const LAS v4u*)(Qs + i * TP + c0 + 8 * j), f);
#pragma unroll
                    for (int e = 0; e < 8; ++e) f[e] *= sc;
                    *(v4u*)(QG + i * 128 + c0 + 8 * j) = pack8(f); } }
            {
                const int d = tt >> 1, i0 = (tt & 1) * 32; const float gl = GCs[63]; bf16* KT = (bf16*)(dnc + DNC_KT) + (size_t)uu * 8192;
#pragma unroll
                for (int j = 0; j < 4; ++j) { float f[8];
#pragma unroll
                    for (int e = 0; e < 8; ++e) { const int i = i0 + 8 * j + e; f[e] = bf2f(Ks[i * TP + d]) * expf(gl - GCs[i]); }
                    *(v4u*)(KT + d * 64 + i0 + 8 * j) = pack8(f); } }
            if (tt == 0) ((float*)(dnc + DNC_GL))[uu] = EGs[63];
        }
    }
}
#undef DNC_FETCH

__device__ __forceinline__ void dn_scan(Frame& F, int L) {
    constexpr int TP = 136, KP = 72, BUF = 62464;
    const int lane = F.lane, w = F.wave, lq = lane & 15, g = lane >> 4;
    unsigned char* dnc = F.ws + WS_DNC; float* ORAW = wsp<float>(F, WS_ORAW);
    for (int ub = F.bid; ub < 32; ub += F.G) {
        const int b = ub >> 2, h = ub & 3;
        f32x4 S[8];
#pragma unroll
        for (int dt = 0; dt < 8; ++dt) S[dt] = (f32x4){0.f, 0.f, 0.f, 0.f};
        v4u st[7];
#define DNS_LOAD(uu) do { _Pragma("unroll") for (int p = 0; p < 7; ++p) { const int q_ = F.tid + 512 * (p & 1); \
            if (p < 2) st[p] = *(const v4u*)((const bf16*)(dnc + DNC_W) + (size_t)(uu) * 8192 + q_ * 8); \
            else if (p < 4) st[p] = *(const v4u*)((const bf16*)(dnc + DNC_QG) + (size_t)(uu) * 8192 + q_ * 8); \
            else if (p < 6) st[p] = *(const v4u*)((const bf16*)(dnc + DNC_KT) + (size_t)(uu) * 8192 + q_ * 8); \
            else st[p] = *(const v4u*)((const bf16*)(dnc + DNC_AQK) + (size_t)(uu) * 4096 + F.tid * 8); } } while (0)
#define DNS_STORE(bufp) do { _Pragma("unroll") for (int p = 0; p < 7; ++p) { const int q_ = F.tid + 512 * (p & 1); \
            if (p < 2) *(LAS v4u*)((bufp) + ((q_ >> 4) * TP + (q_ & 15) * 8) * 2) = st[p]; \
            else if (p < 4) *(LAS v4u*)((bufp) + 17408 + ((q_ >> 4) * TP + (q_ & 15) * 8) * 2) = st[p]; \
            else if (p < 6) *(LAS v4u*)((bufp) + 34816 + ((q_ >> 3) * KP + (q_ & 7) * 8) * 2) = st[p]; \
            else *(LAS v4u*)((bufp) + 53248 + ((F.tid >> 3) * KP + (F.tid & 7) * 8) * 2) = st[p]; } } while (0)
        __syncthreads();
        DNS_LOAD(ub * 32);
        f32x4 ucur[4], unxt[4];
        const float glall = ((const float*)(dnc + DNC_GL))[ub * 32 + (lane & 31)];
        { const f32x4* U0 = (const f32x4*)((const float*)(dnc + DNC_U) + (size_t)(ub * 32) * 8192) + (size_t)w * 256 + lane * 4;
#pragma unroll
          for (int rt = 0; rt < 4; ++rt) { ucur[rt] = U0[rt]; unxt[rt] = (f32x4){0.f, 0.f, 0.f, 0.f}; }
        }
        DNS_STORE(F.lds);
        __syncthreads();
        for (int n = 0; n < 32; ++n) {
            const int uu = ub * 32 + n;
            LAS unsigned char* buf = F.lds + (n & 1) * BUF;
            const LAS bf16* Wn = (const LAS bf16*)buf; const LAS bf16* QG = (const LAS bf16*)(buf + 17408); const LAS bf16* KT = (const LAS bf16*)(buf + 34816); const LAS bf16* AQ = (const LAS bf16*)(buf + 53248);
            { const int un_ = uu + (n < 31 ? 1 : 0); DNS_LOAD(un_);
                const f32x4* U1 = (const f32x4*)((const float*)(dnc + DNC_U) + (size_t)un_ * 8192) + (size_t)w * 256 + lane * 4;
#pragma unroll
                for (int rt = 0; rt < 4; ++rt) unxt[rt] = U1[rt];
            }
            f32x4 vn[4], o[4];
#pragma unroll
            for (int rt = 0; rt < 4; ++rt) { vn[rt] = ucur[rt]; o[rt] = (f32x4){0.f, 0.f, 0.f, 0.f}; }
            const float gl = __shfl(glall, n);
            bf16x8 Sb[4];
#pragma unroll
            for (int ks = 0; ks < 4; ++ks) { v4u t; t.x = pk2(S[2 * ks][0], S[2 * ks][1]); t.y = pk2(S[2 * ks][2], S[2 * ks][3]); t.z = pk2(S[2 * ks + 1][0], S[2 * ks + 1][1]); t.w = pk2(S[2 * ks + 1][2], S[2 * ks + 1][3]); Sb[ks] = __builtin_bit_cast(bf16x8, t); }
#define DNS_FRAG(base, pitch, row, k0) ({ const v2u lo_ = *(const LAS v2u*)((base) + (row) * (pitch) + (k0) + 4 * g), hi_ = *(const LAS v2u*)((base) + (row) * (pitch) + (k0) + 16 + 4 * g); v4u t_; t_.x = lo_.x; t_.y = lo_.y; t_.z = hi_.x; t_.w = hi_.y; __builtin_bit_cast(bf16x8, t_); })
#pragma unroll
            for (int hh = 0; hh < 2; ++hh) {
                bf16x8 fw[8];
#pragma unroll
                for (int rr = 0; rr < 2; ++rr)
#pragma unroll
                    for (int ks = 0; ks < 4; ++ks) fw[4 * rr + ks] = DNS_FRAG(Wn, TP, 16 * (2 * hh + rr) + lq, 32 * ks);
                __builtin_amdgcn_sched_barrier(0);
#pragma unroll
                for (int ks = 0; ks < 4; ++ks)
#pragma unroll
                    for (int rr = 0; rr < 2; ++rr) vn[2 * hh + rr] = __builtin_amdgcn_mfma_f32_16x16x32_bf16(fw[4 * rr + ks], Sb[ks], vn[2 * hh + rr], 0, 0, 0);
                __builtin_amdgcn_sched_barrier(0);
            }
#pragma unroll
            for (int hh = 0; hh < 2; ++hh) {
                bf16x8 fq[8];
#pragma unroll
                for (int rr = 0; rr < 2; ++rr)
#pragma unroll
                    for (int ks = 0; ks < 4; ++ks) fq[4 * rr + ks] = DNS_FRAG(QG, TP, 16 * (2 * hh + rr) + lq, 32 * ks);
                __builtin_amdgcn_sched_barrier(0);
#pragma unroll
                for (int ks = 0; ks < 4; ++ks)
#pragma unroll
                    for (int rr = 0; rr < 2; ++rr) o[2 * hh + rr] = __builtin_amdgcn_mfma_f32_16x16x32_bf16(fq[4 * rr + ks], Sb[ks], o[2 * hh + rr], 0, 0, 0);
                __builtin_amdgcn_sched_barrier(0);
            }
            bf16x8 vb[2];
#pragma unroll
            for (int kt = 0; kt < 2; ++kt) { v4u t; t.x = pk2(vn[2 * kt][0], vn[2 * kt][1]); t.y = pk2(vn[2 * kt][2], vn[2 * kt][3]); t.z = pk2(vn[2 * kt + 1][0], vn[2 * kt + 1][1]); t.w = pk2(vn[2 * kt + 1][2], vn[2 * kt + 1][3]); vb[kt] = __builtin_bit_cast(bf16x8, t); }
            {   bf16x8 fa[6];
                fa[0] = DNS_FRAG(AQ, KP, lq, 0); fa[1] = DNS_FRAG(AQ, KP, 16 + lq, 0); fa[2] = DNS_FRAG(AQ, KP, 32 + lq, 0); fa[3] = DNS_FRAG(AQ, KP, 32 + lq, 32); fa[4] = DNS_FRAG(AQ, KP, 48 + lq, 0); fa[5] = DNS_FRAG(AQ, KP, 48 + lq, 32);
                __builtin_amdgcn_sched_barrier(0);
                o[0] = __builtin_amdgcn_mfma_f32_16x16x32_bf16(fa[0], vb[0], o[0], 0, 0, 0); o[1] = __builtin_amdgcn_mfma_f32_16x16x32_bf16(fa[1], vb[0], o[1], 0, 0, 0);
                o[2] = __builtin_amdgcn_mfma_f32_16x16x32_bf16(fa[2], vb[0], o[2], 0, 0, 0); o[3] = __builtin_amdgcn_mfma_f32_16x16x32_bf16(fa[4], vb[0], o[3], 0, 0, 0);
                o[2] = __builtin_amdgcn_mfma_f32_16x16x32_bf16(fa[3], vb[1], o[2], 0, 0, 0); o[3] = __builtin_amdgcn_mfma_f32_16x16x32_bf16(fa[5], vb[1], o[3], 0, 0, 0);
                __builtin_amdgcn_sched_barrier(0);
            }
#pragma unroll
            for (int dt = 0; dt < 8; ++dt) S[dt] *= gl;
#pragma unroll
            for (int hh = 0; hh < 2; ++hh) {
                bf16x8 fk[8];
#pragma unroll
                for (int dd = 0; dd < 4; ++dd)
#pragma unroll
                    for (int kt = 0; kt < 2; ++kt) fk[2 * dd + kt] = DNS_FRAG(KT, KP, 16 * (4 * hh + dd) + lq, 32 * kt);
                __builtin_amdgcn_sched_barrier(0);
#pragma unroll
                for (int kt = 0; kt < 2; ++kt)
#pragma unroll
                    for (int dd = 0; dd < 4; ++dd) S[4 * hh + dd] = __builtin_amdgcn_mfma_f32_16x16x32_bf16(fk[2 * dd + kt], vb[kt], S[4 * hh + dd], 0, 0, 0);
                __builtin_amdgcn_sched_barrier(0);
            }
            float* op = ORAW + (size_t)(b * 2048 + n * 64) * 512 + h * 128 + 16 * w + lq;
#pragma unroll
            for (int rt = 0; rt < 4; ++rt)
#pragma unroll
                for (int r = 0; r < 4; ++r) op[(size_t)(16 * rt + 4 * g + r) * 512] = o[rt][r];
            DNS_STORE(F.lds + ((n + 1) & 1) * BUF);
#pragma unroll
            for (int rt = 0; rt < 4; ++rt) ucur[rt] = unxt[rt];
            __syncthreads();
        }
        float* so = F.out + O_PDNS + (((size_t)L * 8 + b) * 4 + h) * 128 * 128 + 16 * w + lq;
#pragma unroll
        for (int dt = 0; dt < 8; ++dt)
#pragma unroll
            for (int r = 0; r < 4; ++r) so[(size_t)(16 * dt + 4 * g + r) * 128] = S[dt][r];
#undef DNS_LOAD
#undef DNS_STORE
#undef DNS_FRAG
    }
}
typedef float f2v __attribute__((ext_vector_type(2)));
template <class Epi> __device__ __forceinline__ void thin_gemm(Frame& F, const bf16* A, int lda, const bf16* Bt, int K, int job, const Epi& E) {
    const int lane = F.lane, w = F.wave, lq = lane & 15, g = lane >> 4, rt = job & 7, cg = job >> 3;
    LAS float* red = (LAS float*)F.lds;
    const bf16* ap = A + (size_t)(MP + 16 * rt + lq) * lda + 8 * g;
    const bf16* bp = Bt + (size_t)(64 * cg + lq) * K + 8 * g;
    f32x4 acc[4];
#pragma unroll
    for (int ct = 0; ct < 4; ++ct) acc[ct] = (f32x4){0.f, 0.f, 0.f, 0.f};
    const int nks = K >> 5;
    bf16x8 a[4], b[4][4], an[4], bn[4][4];
#define THIN_LOAD(ks0_, a_, b_) do { _Pragma("unroll") for (int s = 0; s < 4; ++s) { const int ks = (ks0_) + 8 * s; const bool ok = ks < nks; const int kk = ok ? ks : (ks0_); \
            a_[s] = *(const bf16x8*)(ap + 32 * kk); \
            _Pragma("unroll") for (int ct = 0; ct < 4; ++ct) b_[s][ct] = *(const bf16x8*)(bp + (size_t)(16 * ct) * K + 32 * kk); \
            if (!ok) a_[s] = (bf16x8){0, 0, 0, 0, 0, 0, 0, 0}; } } while (0)
    if (w < nks) THIN_LOAD(w, a, b);
#pragma unroll 1
    for (int ks0 = w; ks0 < nks; ks0 += 32) {
        const bool hn = ks0 + 32 < nks;
        if (hn) THIN_LOAD(ks0 + 32, an, bn);
        __builtin_amdgcn_sched_barrier(0);
#pragma unroll
        for (int s = 0; s < 4; ++s)
#pragma unroll
            for (int ct = 0; ct < 4; ++ct) acc[ct] = __builtin_amdgcn_mfma_f32_16x16x32_bf16(a[s], b[s][ct], acc[ct], 0, 0, 0);
        if (hn) {
#pragma unroll
            for (int s = 0; s < 4; ++s) { a[s] = an[s];
#pragma unroll
                for (int ct = 0; ct < 4; ++ct) b[s][ct] = bn[s][ct]; } }
    }
#undef THIN_LOAD
    __syncthreads();
#pragma unroll
    for (int ct = 0; ct < 4; ++ct)
#pragma unroll
        for (int r = 0; r < 4; ++r) red[(w * 16 + 4 * g + r) * 64 + 16 * ct + lq] = acc[ct][r];
    __syncthreads();
    const int row = F.tid >> 5, c2 = 2 * (F.tid & 31);
    float v0 = 0.f, v1 = 0.f;
#pragma unroll
    for (int ww = 0; ww < 8; ++ww) { const f2v p = *(const LAS f2v*)(red + (ww * 16 + row) * 64 + c2); v0 += p[0]; v1 += p[1]; }
    E(v0, v1, MP + 16 * rt + row, 64 * cg + c2, cg, F.tid);
    __syncthreads();
}
__device__ __forceinline__ float sum32(float v) {
    return xsum16(sum16(v));
}
struct ThinResid {
    const float* xin; float* xout; bf16* xb; float* ssq; float scale;
    __device__ __forceinline__ void operator()(float v0, float v1, int row, int col, int cg, int F_tid) const {
        const size_t off = (size_t)row * 1024 + col; const f2v xi = *(const f2v*)(xin + off);
        const float x0 = xi[0] + scale * v0, x1 = xi[1] + scale * v1;
        *(f2v*)(xout + off) = (f2v){x0, x1}; *(unsigned*)(xb + off) = pk2(x0, x1);
        const float ss = sum32(x0 * x0 + x1 * x1);
        if ((F_tid & 31) == 0) ssq[(size_t)row * 16 + cg] = ss;
    }
};
struct ThinGate {
    const bf16* P; bf16* mb; int branch;
    __device__ __forceinline__ void operator()(float v0, float v1, int row, int col, int cg, int F_tid) const {
        const size_t off = (size_t)row * 1024 + col; const unsigned gw = *(const unsigned*)(P + (size_t)row * NINP + PC_GATE + branch * 1024 + col);
        float x0 = bflo(gw) * v0, x1 = bfhi(gw) * v1;
        if (branch > 0) { const unsigned mw = *(const unsigned*)(mb + off); x0 += bflo(mw); x1 += bfhi(mw); }
        *(unsigned*)(mb + off) = pk2(x0, x1);
    }
};
__device__ __forceinline__ void thin_gate4(Frame& F, const bf16* odn, const bf16* wb, const bf16* P, bf16* mb, int job) {
    const int lane = F.lane, w = F.wave, lq = lane & 15, g = lane >> 4, rt = job & 7, cg = job >> 3, br = w >> 1, kh = w & 1;
    LAS float* red = (LAS float*)F.lds;
    const bf16* ap = odn + (size_t)br * MT * 512 + (size_t)(MP + 16 * rt + lq) * 512 + 256 * kh + 8 * g;
    const bf16* bp = wb + (size_t)br * 1024 * 512 + (size_t)(64 * cg + lq) * 512 + 256 * kh + 8 * g;
    f32x4 acc[4];
#pragma unroll
    for (int ct = 0; ct < 4; ++ct) acc[ct] = (f32x4){0.f, 0.f, 0.f, 0.f};
#pragma unroll 1
    for (int s0 = 0; s0 < 8; s0 += 4) {
        bf16x8 a[4], b[4][4];
#pragma unroll
        for (int s = 0; s < 4; ++s) { a[s] = *(const bf16x8*)(ap + 32 * (s0 + s));
#pragma unroll
            for (int ct = 0; ct < 4; ++ct) b[s][ct] = *(const bf16x8*)(bp + (size_t)(16 * ct) * 512 + 32 * (s0 + s)); }
        __builtin_amdgcn_sched_barrier(0);
#pragma unroll
        for (int s = 0; s < 4; ++s)
#pragma unroll
            for (int ct = 0; ct < 4; ++ct) acc[ct] = __builtin_amdgcn_mfma_f32_16x16x32_bf16(a[s], b[s][ct], acc[ct], 0, 0, 0);
    }
    __syncthreads();
#pragma unroll
    for (int ct = 0; ct < 4; ++ct)
#pragma unroll
        for (int r = 0; r < 4; ++r) red[(w * 16 + 4 * g + r) * 64 + 16 * ct + lq] = acc[ct][r];
    __syncthreads();
    const int row = F.tid >> 5, c2 = 2 * (F.tid & 31); const size_t grow = MP + 16 * rt + row; const int col = 64 * cg + c2;
    unsigned gw[4];
#pragma unroll
    for (int bb = 0; bb < 4; ++bb) gw[bb] = *(const unsigned*)(P + grow * NINP + PC_GATE + bb * 1024 + col);
    float x0 = 0.f, x1 = 0.f;
#pragma unroll
    for (int bb = 0; bb < 4; ++bb) { const f2v p0 = *(const LAS f2v*)(red + ((2 * bb) * 16 + row) * 64 + c2), p1 = *(const LAS f2v*)(red + ((2 * bb + 1) * 16 + row) * 64 + c2);
        x0 += bflo(gw[bb]) * (p0[0] + p1[0]); x1 += bfhi(gw[bb]) * (p0[1] + p1[1]); }
    *(unsigned*)(mb + grow * 1024 + col) = pk2(x0, x1);
    __syncthreads();
}
struct ThinPlain {
    bf16* O; int ldo;
    __device__ __forceinline__ void operator()(float v0, float v1, int row, int col, int cg, int F_tid) const { *(unsigned*)(O + (size_t)row * ldo + col) = pk2(v0, v1); }
};
constexpr int N_PHASES = 3 + 12 * DEPTH;
constexpr int WF0 = 0, WF1 = 1500, WF2 = 2400, WF3 = 3500, WF4 = 7320, WF5 = 8320, WF6 = 12720, WF7 = PER_L1;
static_assert(WF7 == 14720 && WF6 < WF7, "deferred conversion slots");
#ifndef MK_ONE_LAUNCH
#define MK_ONE_LAUNCH 1
#endif
__global__ void __launch_bounds__(NWAVES * 64, 2) mk_fwd(Args args) {
    extern __shared__ __attribute__((aligned(16))) unsigned char lds_raw[];
    Frame F;
    F.lds = (LAS unsigned char*)lds_raw;
    F.tid = threadIdx.x; F.lane = F.tid & 63; F.wave = __builtin_amdgcn_readfirstlane(F.tid >> 6); F.wave0 = F.wave;
    F.G = gridDim.x; F.bid = blockIdx.x;
    F.in = (const float* const*)(args.ws + WS_TAB); F.page_table = args.page_table; F.out = args.out; F.ws = args.ws;
    volatile LAS unsigned* MISC = (volatile LAS unsigned*)(F.lds + MISC_OFF);
    for (int u = F.tid; u < (LDS_BYTES - RING_BYTES) / 4; u += NWAVES * 64) ((LAS unsigned*)(F.lds + RING_BYTES))[u] = 0u;
    __syncthreads();
    const int lo = args.ph_lo, hi = args.ph_hi;
    XcdBarrier bar; bar.bar = (unsigned*)(F.ws + WS_CTL) + CW_BAR; bar.x = 0; bar.st = nullptr; bar.w0 = F.wave0;
    if (hi - lo > 1) bar = xcd_barrier_post((unsigned*)(F.ws + WS_CTL) + CW_BAR, MISC + 8, F.wave0);
#define IN(k) (lo <= (k) && (k) < hi)
#define SEAM(k) do { if (IN(k) && IN((k) + 1)) xcd_barrier(bar); } while (0)
    using namespace pg8;
    if (IN(0)) {
        if (F.bid == 0 && F.tid == 0) { const float** tab = (const float**)(args.ws + WS_TAB);
#pragma unroll
            for (int i = 0; i < 39; ++i) tab[i] = args.in[i]; }
        launder(F); p0_weights(F, args, F.G == 256); launder(F); p0_rows(F, args); }
    SEAM(0);
    for (int L = 0; L < DEPTH; ++L) {
        const int pb = 3 + 12 * L;
        const bool last = (L == DEPTH - 1);
        if (IN(pb + 0)) { launder(F);
            Gemm g{wsp<bf16>(F, WS_XB), wl(F, L, WL_GU1), MT, 5632, 1024, 1024}; StaticOrder S; S.init(MT, 5632, F.G, F.bid);
            EpiSwiglu E{wsp<bf16>(F, WS_ACT), DFF, ssqbuf(F, 3 * L)};
            gemm_phase<EpiSwiglu, StaticOrder, true, true>(F.lds, g, S, E, F.tid);
            if (L == 0) {
                launder(F);
                const int short0 = (65 * 22) % F.G, vb = F.bid - short0;
                if (short0 > 0 && F.G - short0 >= 64) { if (vb >= 0 && vb < 64) { Gemm g2{wsp<bf16>(F, WS_MEMB), wsp<bf16>(F, WS_WMEMKV), 2048, 2048, 1024, 1024}; StaticOrder S2; S2.init(2048, 2048, 64, vb);
                        EpiMemKV E2{F.out + O_PMK, (size_t)(O_PMV - O_PMK)}; gemm_phase<EpiMemKV, StaticOrder, true, true>(F.lds, g2, S2, E2, F.tid); } }
                else { Gemm g2{wsp<bf16>(F, WS_MEMB), wsp<bf16>(F, WS_WMEMKV), 2048, 2048, 1024, 1024}; StaticOrder S2; S2.init(2048, 2048, F.G, F.bid);
                        EpiMemKV E2{F.out + O_PMK, (size_t)(O_PMV - O_PMK)}; gemm_phase<EpiMemKV, StaticOrder, true, true>(F.lds, g2, S2, E2, F.tid); }
            }
            if (L == 0 && F.G == 256 && F.bid >= 214) { __syncthreads(); launder(F); w1_fill(F, F.bid - 214, 42, WF0, WF1); }
        }
        SEAM(pb + 0);
        if (IN(pb + 1)) { launder(F);
            Gemm g{wsp<bf16>(F, WS_ACT), wl(F, L, WL_D1), MP, 1024, DFF, DFF}; StaticOrder S; S.init(MP, 1024, F.G, F.bid);
            EpiResid E{wsp<float>(F, WS_X), wsp<float>(F, WS_X), wsp<bf16>(F, WS_XB), ssqbuf(F, 3 * L + 1), 0.5f, MT};
            gemm_phase<EpiResid, StaticOrder, true, true>(F.lds, g, S, E, F.tid);
            launder(F);
            if (F.bid < 128) { ThinResid T{wsp<float>(F, WS_X), wsp<float>(F, WS_X), wsp<bf16>(F, WS_XB), ssqbuf(F, 3 * L + 1), 0.5f}; thin_gemm(F, wsp<bf16>(F, WS_ACT), DFF, wl(F, L, WL_D1), DFF, F.bid, T); }
            if (L == 0) { launder(F); if (F.G > 128) { if (F.bid >= 128) p2_memkv_post(F, F.bid - 128, F.G - 128); } else p2_memkv_post(F, F.bid, F.G); }
            if (L == 0 && F.G == 256 && F.bid >= 128) { __syncthreads(); launder(F); w1_fill(F, F.bid - 128, 128, WF1, WF2); }
        }
        SEAM(pb + 1);
        if (IN(pb + 2)) { launder(F);
            Gemm g{wsp<bf16>(F, WS_XB), wl(F, L, WL_IN), MT, NINP, 1024, 1024}; StaticOrder S; S.init(MT, NINP, F.G, F.bid);
            EpiWin E{wsp<bf16>(F, WS_P), wsp<float>(F, WS_SIDE), ssqbuf(F, 3 * L + 1)};
            gemm_phase<EpiWin, StaticOrder, true, true>(F.lds, g, S, E, F.tid);
            if (L == 0 && F.G == 256 && F.bid >= 227) { __syncthreads(); launder(F); w1_fill(F, F.bid - 227, 29, WF2, WF3); }
        }
        SEAM(pb + 2);
        if (IN(pb + 3)) { launder(F); prep_rows(F, L); }
        SEAM(pb + 3);
        if (IN(pb + 4)) { launder(F);
            {
                Gemm g{wsp<bf16>(F, WS_CQB), wl(F, L, WL_QB), MP, 1024, launder_int(256), 256}; MultiOrder S; S.init(MP, 1024, F.G, F.bid); S.nb = 2; S.pmstride = 65; S.pnstride = 4;
                EpiPlainM E{wsp<bf16>(F, WS_QRAW), (size_t)MT * 1024};
                gemm_phase<EpiPlainM, MultiOrder, true, true>(F.lds, g, S, E, F.tid);
            }
#pragma unroll 1
            for (int i = 0; i < 2; ++i) { launder(F);
                const int job = F.G >= 256 ? (i == 0 ? F.bid : F.bid - 128) : F.bid;
                if (job >= 0 && job < 128) { ThinPlain T{wsp<bf16>(F, WS_QRAW + (size_t)i * (WS_KVRAW - WS_QRAW)), 1024}; thin_gemm(F, wsp<bf16>(F, WS_CQB + (size_t)i * (WS_CKVB - WS_CQB)), 256, wl(F, L, WL_QB + (size_t)i * (WL_KVB - WL_QB)), 256, job, T); }
            }
            launder(F); dn_chunk_prep(F, L);
        }
        SEAM(pb + 4);
        if (IN(pb + 5)) { launder(F); mla_post(F, L); launder(F); wuk_swizzle(F, L); }
        SEAM(pb + 5);
        if (IN(pb + 6)) { launder(F); dn_scan(F, L); __syncthreads(); launder(F); dn_seq(F, L); __syncthreads(); launder(F); mla_prompt_attn(F); __syncthreads(); launder(F); mem_attn(F, L); __syncthreads(); launder(F); mla_sample_attn(F, L); }
        SEAM(pb + 6);
        if (IN(pb + 7)) { launder(F); mla_sample_combine(F, L); launder(F); dn_post(F, L); }
        SEAM(pb + 7);
        if (IN(pb + 8)) { launder(F);
            if (F.bid < 128) thin_gate4(F, wsp<bf16>(F, WS_ODN), wl(F, L, WL_DNO), wsp<bf16>(F, WS_P), wsp<bf16>(F, WS_MB), F.bid);
            __syncthreads(); launder(F);
            {
                Gemm g{wsp<bf16>(F, WS_ODN), wl(F, L, WL_DNO), MP, 1024, 512, 512}; MultiOrder S; S.init(MP, 1024, F.G, F.bid); S.nb = 4; S.pmstride = 65; S.pnstride = 4;
                EpiGateM E{wsp<bf16>(F, WS_P), wsp<bf16>(F, WS_MB)};
                gemm_phase<EpiGateM, MultiOrder, true, true>(F.lds, g, S, E, F.tid);
            }
            if (L == 0 && F.G == 256) { __syncthreads(); launder(F); if (F.bid >= 128) w1_fill(F, F.bid - 128, 128, WF3 + 1140, WF4); else w1_fill(F, F.bid, 128, WF3, WF3 + 1140); }
        }
        SEAM(pb + 8);
        if (IN(pb + 9)) { launder(F);
            Gemm g{wsp<bf16>(F, WS_MB), wl(F, L, WL_WO), MP, 1024, 1024, 1024}; StaticOrder S; S.init(MP, 1024, F.G, F.bid);
            EpiResid E{wsp<float>(F, WS_X), wsp<float>(F, WS_X), wsp<bf16>(F, WS_XB), ssqbuf(F, 3 * L + 2), 1.0f, MT};
            gemm_phase<EpiResid, StaticOrder, true, true>(F.lds, g, S, E, F.tid);
            launder(F);
            if (F.bid < 128) { ThinResid T{wsp<float>(F, WS_X), wsp<float>(F, WS_X), wsp<bf16>(F, WS_XB), ssqbuf(F, 3 * L + 2), 1.0f}; thin_gemm(F, wsp<bf16>(F, WS_MB), 1024, wl(F, L, WL_WO), 1024, F.bid, T); }
            if (L == 0 && F.G == 256 && F.bid >= 128) { __syncthreads(); launder(F); w1_fill(F, F.bid - 128, 128, WF4, WF5); }
        }
        SEAM(pb + 9);
        if (IN(pb + 10)) { launder(F);
            Gemm g{wsp<bf16>(F, WS_XB), wl(F, L, WL_GU2), MT, 5632, 1024, 1024}; StaticOrder S; S.init(MT, 5632, F.G, F.bid);
            EpiSwiglu E{wsp<bf16>(F, WS_ACT), DFF, ssqbuf(F, 3 * L + 2)};
            gemm_phase<EpiSwiglu, StaticOrder, true, true>(F.lds, g, S, E, F.tid);
            if (L == 0 && F.G == 256 && F.bid >= 150) { __syncthreads(); launder(F); w1_fill(F, F.bid - 150, 106, WF5, WF6); }
        }
        SEAM(pb + 10);
        if (IN(pb + 11)) { launder(F);
            Gemm g{wsp<bf16>(F, WS_ACT), wl(F, L, WL_D2), MP, 1024, DFF, DFF}; StaticOrder S; S.init(MP, 1024, F.G, F.bid);
            EpiResid E{wsp<float>(F, WS_X), last ? F.out : wsp<float>(F, WS_X), wsp<bf16>(F, WS_XB), ssqbuf(F, 3 * L + 3), 0.5f, last ? MV : MT};
            gemm_phase<EpiResid, StaticOrder, true, true>(F.lds, g, S, E, F.tid);
            launder(F);
            if (F.bid < 128) { ThinResid T{wsp<float>(F, WS_X), last ? F.out : wsp<float>(F, WS_X), wsp<bf16>(F, WS_XB), ssqbuf(F, 3 * L + 3), 0.5f}; thin_gemm(F, wsp<bf16>(F, WS_ACT), DFF, wl(F, L, WL_D2), DFF, F.bid, T); }
            if (L == 0 && F.G == 256 && F.bid >= 128) { __syncthreads(); launder(F); w1_fill(F, F.bid - 128, 128, WF6, WF7); }
        }
        SEAM(pb + 11);
    }
#undef IN
#undef SEAM
}

extern "C" void kernel_launch(void* const* d_in, const int* in_sizes, int n_in, void* d_out, int out_size, void* d_ws, size_t ws_size, hipStream_t stream) {
    static int grid = 0;
    if (grid == 0) {
        if (n_in != 39 || out_size != (int)O_END || ws_size < WS_END) { fprintf(stderr, "kernel_launch: unexpected sizes n_in %d out %d ws %zu (need %zu)\n", n_in, out_size, ws_size, (size_t)WS_END); grid = -1; return; }
        int dev = 0, cus = 0;
        if (hipGetDevice(&dev) != hipSuccess || hipDeviceGetAttribute(&cus, hipDeviceAttributeMultiprocessorCount, dev) != hipSuccess) { grid = -1; return; }
        if (hipFuncSetAttribute((const void*)mk_fwd, hipFuncAttributeMaxDynamicSharedMemorySize, LDS_BYTES) != hipSuccess) { fprintf(stderr, "kernel_launch: hipFuncSetAttribute failed\n"); grid = -1; return; }
        int per_cu = 0;
        if (hipOccupancyMaxActiveBlocksPerMultiprocessor(&per_cu, (const void*)mk_fwd, NWAVES * 64, LDS_BYTES) != hipSuccess || per_cu < 1) fprintf(stderr, "kernel_launch: occupancy query reports %d\n", per_cu);
        (void)hipGetLastError();
        grid = cus;
    }
    if (grid < 0) return;
    (void)hipMemsetAsync((char*)d_ws + WS_CTL, 0, CTL_ZERO_BYTES, stream);
    Args a{};
    for (int i = 0; i < 39; ++i) a.in[i] = (const float*)d_in[i];
    a.page_table = (const int*)d_in[9]; a.out = (float*)d_out; a.ws = (unsigned char*)d_ws;
#if MK_ONE_LAUNCH
    a.ph_lo = 0; a.ph_hi = N_PHASES;
    hipLaunchKernelGGL(mk_fwd, dim3(grid), dim3(NWAVES * 64), LDS_BYTES, stream, a);
#else
    for (int p = 0; p < N_PHASES; ++p) { a.ph_lo = p; a.ph_hi = p + 1; hipLaunchKernelGGL(mk_fwd, dim3(grid), dim3(NWAVES * 64), LDS_BYTES, stream, a); }
#endif
}
```
